# Optimizing an MI355X kernel written in HIP

```python
import jax, jax.numpy as jnp
from jax import lax
import numpy as np

D_MODEL = 2048
BATCH = 4
SEQ = 4096
DEPTH = 1

MEM_TOKENS = 256
HEAD_DIM = 64
N_Q_HEADS = 16
N_KV_HEADS = 4
Q_PER_KV = N_Q_HEADS // N_KV_HEADS
ATTN_WIDTH = N_Q_HEADS * HEAD_DIM
KV_WIDTH = N_KV_HEADS * HEAD_DIM
WINDOW = 128
BLOCK = 128
ROPE_THETA = 10000.0
CONV_WIDTH = 1024
CONV_K = 3
X_HEADS = 4
X_HEAD_DIM = 128
X_WIDTH = X_HEADS * X_HEAD_DIM
FFN_HIDDEN = -(-(8 * D_MODEL) // (3 * 256)) * 256
EPS = 1e-6
IN_SIZES = (ATTN_WIDTH, KV_WIDTH, KV_WIDTH, CONV_WIDTH, CONV_WIDTH, CONV_WIDTH, D_MODEL, D_MODEL)
IN_WIDTH = ATTN_WIDTH + 2 * KV_WIDTH + 3 * CONV_WIDTH + 2 * D_MODEL

kernel_name = "hybrid_gated_swa_shortconv_xattn_block"


def rms_norm(x, g):
    xf = x.astype(jnp.float32)
    y = xf * lax.rsqrt(jnp.mean(xf * xf, axis=-1, keepdims=True) + EPS)
    return (y * g.astype(jnp.float32)).astype(x.dtype)


def rope(x, positions):
    half = HEAD_DIM // 2
    inv_freq = ROPE_THETA ** (-jnp.arange(half, dtype=jnp.float32) / half)
    ang = positions.astype(jnp.float32)[:, None] * inv_freq[None, :]
    cos = jnp.cos(ang)[None, :, None, :]
    sin = jnp.sin(ang)[None, :, None, :]
    xf = x.astype(jnp.float32)
    x1, x2 = xf[..., :half], xf[..., half:]
    out = jnp.concatenate([x1 * cos - x2 * sin, x2 * cos + x1 * sin], axis=-1)
    return out.astype(x.dtype)


def _with_prev_block(t):
    pad = [(0, 0)] * t.ndim
    pad[1] = (1, 0)
    prev = jnp.pad(t, pad)[:, :-1]
    return jnp.concatenate([prev, t], axis=2)


def sliding_window_attention(q, k, v, sinks):
    b, t = q.shape[0], q.shape[1]
    nb = t // BLOCK
    qb = q.reshape(b, nb, BLOCK, N_KV_HEADS, Q_PER_KV, HEAD_DIM)
    kband = _with_prev_block(k.reshape(b, nb, BLOCK, N_KV_HEADS, HEAD_DIM))
    vband = _with_prev_block(v.reshape(b, nb, BLOCK, N_KV_HEADS, HEAD_DIM))
    scale = HEAD_DIM ** -0.5
    s = jnp.einsum('bnqhgd,bnkhd->bnhgqk', qb, kband).astype(jnp.float32) * scale
    blk = jnp.arange(nb)[:, None]
    q_pos = blk * BLOCK + jnp.arange(BLOCK)[None, :]
    k_pos = (blk - 1) * BLOCK + jnp.arange(2 * BLOCK)[None, :]
    diff = q_pos[:, :, None] - k_pos[:, None, :]
    valid = (diff >= 0) & (diff < WINDOW) & (k_pos[:, None, :] >= 0)
    s = jnp.where(valid[None, :, None, None, :, :], s, -jnp.inf)
    sink = sinks.astype(jnp.float32).reshape(N_KV_HEADS, Q_PER_KV)[None, None, :, :, None, None]
    m = jnp.maximum(jnp.max(s, axis=-1, keepdims=True), sink)
    p = jnp.exp(s - m)
    p = p / (jnp.sum(p, axis=-1, keepdims=True) + jnp.exp(sink - m))
    o = jnp.einsum('bnhgqk,bnkhd->bnqhgd', p.astype(v.dtype), vband)
    return o.reshape(b, t, ATTN_WIDTH)


def short_gated_conv(z, gate_b, gate_c, conv_w):
    t = z.shape[1]
    cz = gate_c * z
    zp = jnp.pad(cz, ((0, 0), (CONV_K - 1, 0), (0, 0)))
    y = conv_w[0] * zp[:, 0:t]
    for j in range(1, CONV_K):
        y = y + conv_w[j] * zp[:, j:j + t]
    return gate_b * y


def cross_attention(u, mem_n, w_xq, w_xkv, w_xo):
    b, t = u.shape[0], u.shape[1]
    q = (u @ w_xq).reshape(b, t, X_HEADS, X_HEAD_DIM)
    kv = mem_n @ w_xkv
    k = kv[..., :X_WIDTH].reshape(b, -1, X_HEADS, X_HEAD_DIM)
    v = kv[..., X_WIDTH:].reshape(b, -1, X_HEADS, X_HEAD_DIM)
    s = jnp.einsum('bthd,bmhd->bhtm', q, k).astype(jnp.float32) * (X_HEAD_DIM ** -0.5)
    p = jax.nn.softmax(s, axis=-1)
    o = jnp.einsum('bhtm,bmhd->bthd', p.astype(v.dtype), v).reshape(b, t, X_WIDTH)
    return o @ w_xo


def setup_inputs(seed: int = 0) -> dict:
    key = jax.random.key(seed)
    ks = jax.random.split(key, 20)
    f32 = jnp.float32

    def w(k, shape, fan_in):
        return jax.random.normal(k, shape, f32) * (fan_in ** -0.5)

    def gain(k, shape):
        return 1.0 + 0.01 * jax.random.normal(k, shape, f32)

    return {
        "x": jax.random.normal(ks[0], (BATCH, SEQ, D_MODEL), f32),
        "mem": jax.random.normal(ks[1], (BATCH, MEM_TOKENS, D_MODEL), f32),
        "g_mix": gain(ks[2], (DEPTH, D_MODEL)),
        "w_in": w(ks[3], (DEPTH, D_MODEL, IN_WIDTH), D_MODEL),
        "conv_w": w(ks[4], (DEPTH, CONV_K, CONV_WIDTH), CONV_K),
        "attn_sinks": 0.5 * jax.random.normal(ks[5], (DEPTH, N_Q_HEADS), f32),
        "w_attn_proj": w(ks[6], (DEPTH, ATTN_WIDTH, D_MODEL), ATTN_WIDTH),
        "w_conv_proj": w(ks[7], (DEPTH, CONV_WIDTH, D_MODEL), CONV_WIDTH),
        "w_mix_out": w(ks[8], (DEPTH, D_MODEL, D_MODEL), D_MODEL),
        "g_xattn": gain(ks[9], (DEPTH, D_MODEL)),
        "g_mem": gain(ks[10], (DEPTH, D_MODEL)),
        "w_xq": w(ks[11], (DEPTH, D_MODEL, X_WIDTH), D_MODEL),
        "w_xkv": w(ks[12], (DEPTH, D_MODEL, 2 * X_WIDTH), D_MODEL),
        "w_xo": w(ks[13], (DEPTH, X_WIDTH, D_MODEL), X_WIDTH),
        "g_ffn": gain(ks[14], (DEPTH, D_MODEL)),
        "w_ffn_in": w(ks[15], (DEPTH, D_MODEL, 2 * FFN_HIDDEN), D_MODEL),
        "w_ffn_out": w(ks[16], (DEPTH, FFN_HIDDEN, D_MODEL), FFN_HIDDEN),
        "g_final": gain(ks[17], (D_MODEL,)),
    }


def reference(x, mem, g_mix, w_in, conv_w, attn_sinks, w_attn_proj, w_conv_proj, w_mix_out,
              g_xattn, g_mem, w_xq, w_xkv, w_xo, g_ffn, w_ffn_in, w_ffn_out, g_final):
    b, t = x.shape[0], x.shape[1]
    positions = jnp.arange(t, dtype=jnp.int32)
    split_points = np.cumsum(IN_SIZES)[:-1].tolist()
    h = x
    for l in range(DEPTH):
        u = rms_norm(h, g_mix[l])
        proj = u @ w_in[l]
        q, k, v, z, gb, gc, gate_a, gate_c = jnp.split(proj, split_points, axis=-1)
        q = rope(q.reshape(b, t, N_Q_HEADS, HEAD_DIM), positions)
        k = rope(k.reshape(b, t, N_KV_HEADS, HEAD_DIM), positions)
        v = v.reshape(b, t, N_KV_HEADS, HEAD_DIM)
        y_attn = sliding_window_attention(q, k, v, attn_sinks[l]) @ w_attn_proj[l]
        y_conv = short_gated_conv(z, gb, gc, conv_w[l]) @ w_conv_proj[l]
        merged = jax.nn.sigmoid(gate_a) * y_attn + jax.nn.sigmoid(gate_c) * y_conv
        h = h + merged @ w_mix_out[l]
        u = rms_norm(h, g_xattn[l])
        mem_n = rms_norm(mem, g_mem[l])
        h = h + cross_attention(u, mem_n, w_xq[l], w_xkv[l], w_xo[l])
        u = rms_norm(h, g_ffn[l])
        hid = u @ w_ffn_in[l]
        h = h + (jax.nn.silu(hid[..., :FFN_HIDDEN]) * hid[..., FFN_HIDDEN:]) @ w_ffn_out[l]
    return rms_norm(h, g_final)
```

```cpp
#include <hip/hip_runtime.h>
#include <stdint.h>

typedef unsigned short bf16_t;
__device__ __forceinline__ float bf2f(bf16_t b) { return __uint_as_float(((unsigned)b) << 16); }
__device__ __forceinline__ bf16_t f2bf(float f) { unsigned u = __float_as_uint(f); return (bf16_t)((u + 0x7fffu + ((u >> 16) & 1u)) >> 16); }
__device__ __forceinline__ float rbf(float f) { return bf2f(f2bf(f)); }

constexpr int D = 2048, BATCH = 4, SEQ = 4096, M = BATCH * SEQ, MEMT = 256, MM = BATCH * MEMT;
constexpr int INW = 8704, FFN = 5632, XW = 512;
constexpr float EPS = 1e-6f;
constexpr float LOG2E = 1.4426950408889634f;
constexpr float QSCALE = 0.125f * LOG2E;
constexpr float XSCALE = 0.08838834764831845f * LOG2E;

constexpr size_t MiB = 1u << 20;
constexpr size_t WS_SS = 0;
constexpr size_t WS_ROPE = 1 * MiB;
constexpr size_t WS_MEMN = 2 * MiB;
constexpr size_t WS_KX = 6 * MiB;
constexpr size_t WS_VXT = 7 * MiB;
constexpr size_t WS_ACT0 = 132 * MiB;
constexpr size_t WS_XB = WS_ACT0;
constexpr size_t WS_Q = WS_XB + 64 * MiB;
constexpr size_t WS_K = WS_Q + 32 * MiB;
constexpr size_t WS_V = WS_K + 8 * MiB;
constexpr size_t WS_CZ = WS_V + 8 * MiB;
constexpr size_t WS_GB = WS_CZ + 32 * MiB;
constexpr size_t WS_SA = WS_GB + 32 * MiB;
constexpr size_t WS_SC = WS_SA + 64 * MiB;
constexpr size_t WS_HB = WS_SC + 64 * MiB;
constexpr size_t WS_ACT = WS_CZ;
constexpr size_t WS_END = WS_HB + 64 * MiB;

__device__ __forceinline__ float wave_sum(float v) {
#pragma unroll
    for (int o = 1; o < 64; o <<= 1) v += __shfl_xor(v, o);
    return v;
}

__global__ __launch_bounds__(256) void k_prep(const float* x, const float* mem, const float* g_mem, bf16_t* xb, float* ss0, bf16_t* memn, float* rope) {
    const int lane = threadIdx.x & 63, gw = blockIdx.x * 4 + (threadIdx.x >> 6), NW = gridDim.x * 4;
    for (int m = gw; m < M; m += NW) {
        const float* r = x + (size_t)m * D; float s = 0.f;
        for (int j = lane; j < D; j += 64) { float v = r[j]; s += v * v; xb[(size_t)m * D + j] = f2bf(v); }
        s = wave_sum(s); if (lane == 0) ss0[m] = s;
    }
    for (int m = gw; m < MM; m += NW) {
        const float* r = mem + (size_t)m * D; float s = 0.f;
        for (int j = lane; j < D; j += 64) { float v = r[j]; s += v * v; }
        s = wave_sum(s); const float rs = rsqrtf(s * (1.f / D) + EPS);
        for (int j = lane; j < D; j += 64) memn[(size_t)m * D + j] = f2bf(r[j] * rs * g_mem[j]);
    }
    const int gt = blockIdx.x * 256 + threadIdx.x, NT = gridDim.x * 256;
    for (int e = gt; e < 4096 * 32; e += NT) {
        const int t = e >> 5, i = e & 31;
        const float inv = (float)exp(-(double)i / 32.0 * 9.210340371976184);
        const float ang = (float)t * inv;
        double rev = (double)ang * 0.15915494309189535; rev -= floor(rev + 0.5);
        const double xr = rev * 6.283185307179586, x2 = xr * xr;
        double sn = 0.0, cs = 0.0, ts = xr, tc = 1.0;
#pragma unroll
        for (int n = 0; n < 14; ++n) { cs += tc; sn += ts; tc *= -x2 / (double)((2 * n + 1) * (2 * n + 2)); ts *= -x2 / (double)((2 * n + 2) * (2 * n + 3)); }
        rope[e] = (float)cs; rope[4096 * 32 + e] = (float)sn;
    }
}

template <class F>
__global__ __launch_bounds__(256) void gemm_naive(const bf16_t* __restrict__ A, int K, const float* __restrict__ W, int ldw, const float* __restrict__ gk, F f) {
    __shared__ float As[16][68], B1[16][68], B2[16][68];
    const int tid = threadIdx.x, tx = tid & 15, ty = tid >> 4;
    const int m0 = blockIdx.y * 64, j0 = blockIdx.x * 64;
    float a1[4][4], a2[4][4];
#pragma unroll
    for (int i = 0; i < 4; ++i)
#pragma unroll
        for (int j = 0; j < 4; ++j) { a1[i][j] = 0.f; a2[i][j] = 0.f; }
    for (int k0 = 0; k0 < K; k0 += 16) {
#pragma unroll
        for (int i = 0; i < 4; ++i) { const int idx = tid + 256 * i, r = idx >> 4, kk = idx & 15; As[kk][r] = bf2f(A[(size_t)(m0 + r) * K + k0 + kk]); }
#pragma unroll
        for (int i = 0; i < 4; ++i) { const int idx = tid + 256 * i, kk = idx >> 6, jj = idx & 63; int c1, c2; f.cols(j0 + jj, c1, c2);
            const float g = gk ? gk[k0 + kk] : 1.f; B1[kk][jj] = rbf(W[(size_t)(k0 + kk) * ldw + c1] * g); if (F::PAIR) B2[kk][jj] = rbf(W[(size_t)(k0 + kk) * ldw + c2] * g); }
        __syncthreads();
#pragma unroll
        for (int kk = 0; kk < 16; ++kk) {
            float a[4], b1[4], b2[4];
#pragma unroll
            for (int i = 0; i < 4; ++i) { a[i] = As[kk][ty * 4 + i]; b1[i] = B1[kk][tx * 4 + i]; b2[i] = F::PAIR ? B2[kk][tx * 4 + i] : 0.f; }
#pragma unroll
            for (int i = 0; i < 4; ++i)
#pragma unroll
                for (int j = 0; j < 4; ++j) { a1[i][j] += a[i] * b1[j]; if (F::PAIR) a2[i][j] += a[i] * b2[j]; }
        }
        __syncthreads();
    }
#pragma unroll
    for (int i = 0; i < 4; ++i)
#pragma unroll
        for (int j = 0; j < 4; ++j) f.epi(m0 + ty * 4 + i, j0 + tx * 4 + j, a1[i][j], a2[i][j]);
}

__device__ __forceinline__ float rstd_of(const float* ss, int m) { return rsqrtf(ss[m] * (1.f / D) + EPS); }

struct EpiRope {
    static constexpr bool PAIR = true;
    bf16_t* o; int ld; int cbase; const float* ss; const float* rope; float scale; int pad;
    __device__ void cols(int j, int& c1, int& c2) const { c1 = cbase + (j >> 5) * 64 + (j & 31); c2 = c1 + 32; }
    __device__ void epi(int m, int j, float v1, float v2) const {
        const float r = rstd_of(ss, m), x1 = v1 * r, x2 = v2 * r; const int t = m & (SEQ - 1), i = j & 31;
        const float c = rope[t * 32 + i], s = rope[4096 * 32 + t * 32 + i];
        const size_t off = (size_t)m * ld + (j >> 5) * 64 + i;
        o[off] = f2bf((x1 * c - x2 * s) * scale); o[off + 32] = f2bf((x2 * c + x1 * s) * scale);
    }
};
struct EpiPlain {
    static constexpr bool PAIR = false;
    bf16_t* o; int ld; int cbase; const float* ss; int act; float scale; int transposed; int pad;
    __device__ void cols(int j, int& c1, int& c2) const { c1 = cbase + j; c2 = c1; }
    __device__ void epi(int m, int j, float v1, float) const {
        float v = v1 * (ss ? rstd_of(ss, m) : 1.f) * scale; if (act == 1) v = 1.f / (1.f + __expf(-v));
        if (transposed) o[(size_t)j * ld + m] = f2bf(v); else o[(size_t)m * ld + j] = f2bf(v);
    }
};
struct EpiMul {
    static constexpr bool PAIR = true;
    bf16_t* o; const float* ss; int ld; int c1base, c2base; int pad;
    __device__ void cols(int j, int& c1, int& c2) const { c1 = c1base + j; c2 = c2base + j; }
    __device__ void epi(int m, int j, float v1, float v2) const { const float r = rstd_of(ss, m); o[(size_t)m * ld + j] = f2bf((v1 * r) * (v2 * r)); }
};
struct EpiFfn {
    static constexpr bool PAIR = true;
    bf16_t* o; const float* ss;
    __device__ void cols(int j, int& c1, int& c2) const { c1 = j; c2 = FFN + j; }
    __device__ void epi(int m, int j, float v1, float v2) const { const float r = rstd_of(ss, m), g = v1 * r, u = v2 * r; o[(size_t)m * FFN + j] = f2bf(g / (1.f + __expf(-g)) * u); }
};
struct EpiT1 {
    static constexpr bool PAIR = false;
    float* t1; const bf16_t* sa;
    __device__ void cols(int j, int& c1, int& c2) const { c1 = j; c2 = j; }
    __device__ void epi(int m, int j, float v1, float) const { const size_t o = (size_t)m * D + j; t1[o] = bf2f(sa[o]) * v1; }
};
struct EpiMerged {
    static constexpr bool PAIR = false;
    const float* t1; const bf16_t* sc; bf16_t* o;
    __device__ void cols(int j, int& c1, int& c2) const { c1 = j; c2 = j; }
    __device__ void epi(int m, int j, float v1, float) const { const size_t off = (size_t)m * D + j; o[off] = f2bf(t1[off] + bf2f(sc[off]) * v1); }
};
struct EpiRes {
    static constexpr bool PAIR = false;
    const float* base; float* out; bf16_t* ob; float* ss;
    __device__ void cols(int j, int& c1, int& c2) const { c1 = j; c2 = j; }
    __device__ void epi(int m, int j, float v1, float) const { const size_t off = (size_t)m * D + j; const float h = base[off] + v1; out[off] = h; if (ob) ob[off] = f2bf(h); if (ss) atomicAdd(ss + m, h * h); }
};

__global__ __launch_bounds__(256) void k_swa(bf16_t* q, const bf16_t* k, const bf16_t* v, const float* sinks) {
    const int lane = threadIdx.x & 63, gw = blockIdx.x * 4 + (threadIdx.x >> 6);
    const int m = gw >> 4, h = gw & 15, hk = h >> 2, t = m & (SEQ - 1), b = m >> 12;
    const float qv = bf2f(q[(size_t)m * 1024 + h * 64 + lane]);
    float mr = sinks[h] * LOG2E, l = 1.f, o = 0.f;
    const int j0 = t - 127 < 0 ? 0 : t - 127;
    for (int j = j0; j <= t; ++j) {
        const size_t kr = (size_t)(b * SEQ + j) * 256 + hk * 64 + lane;
        const float s = wave_sum(qv * bf2f(k[kr]));
        const float mn = fmaxf(mr, s), al = exp2f(mr - mn), p = exp2f(s - mn);
        l = l * al + p; o = o * al + p * bf2f(v[kr]); mr = mn;
    }
    q[(size_t)m * 1024 + h * 64 + lane] = f2bf(o / l);
}
__global__ __launch_bounds__(256) void k_conv(const bf16_t* cz, bf16_t* gb, const float* w) {
    const size_t e = (size_t)blockIdx.x * 256 + threadIdx.x; const int m = (int)(e >> 10), c = (int)(e & 1023), t = m & (SEQ - 1);
    const float z0 = bf2f(cz[e]), z1 = t >= 1 ? bf2f(cz[e - 1024]) : 0.f, z2 = t >= 2 ? bf2f(cz[e - 2048]) : 0.f;
    gb[e] = f2bf(bf2f(gb[e]) * (w[c] * z2 + w[1024 + c] * z1 + w[2048 + c] * z0));
}
__global__ __launch_bounds__(256) void k_xattn(bf16_t* q, const bf16_t* kx, const bf16_t* vxt) {
    const int lane = threadIdx.x & 63, gw = blockIdx.x * 4 + (threadIdx.x >> 6);
    const int m = gw >> 2, h = gw & 3, b = m >> 12;
    const size_t qo = (size_t)m * XW + h * 128 + lane;
    const float q0 = bf2f(q[qo]), q1 = bf2f(q[qo + 64]);
    float mr = -1e30f, l = 0.f, o0 = 0.f, o1 = 0.f;
    for (int j = 0; j < MEMT; ++j) {
        const size_t kr = (size_t)(b * MEMT + j) * XW + h * 128 + lane;
        const float s = wave_sum(q0 * bf2f(kx[kr]) + q1 * bf2f(kx[kr + 64]));
        const float mn = fmaxf(mr, s), al = exp2f(mr - mn), p = exp2f(s - mn);
        l = l * al + p;
        o0 = o0 * al + p * bf2f(vxt[(size_t)(h * 128 + lane) * MM + b * MEMT + j]);
        o1 = o1 * al + p * bf2f(vxt[(size_t)(h * 128 + lane + 64) * MM + b * MEMT + j]);
        mr = mn;
    }
    q[qo] = f2bf(o0 / l); q[qo + 64] = f2bf(o1 / l);
}
__global__ __launch_bounds__(256) void k_final(float* out, const float* g) {
    const int lane = threadIdx.x & 63, m = blockIdx.x * 4 + (threadIdx.x >> 6);
    float* r = out + (size_t)m * D; float v[32]; float s = 0.f;
#pragma unroll
    for (int j = 0; j < 32; ++j) { v[j] = r[lane + 64 * j]; s += v[j] * v[j]; }
    s = wave_sum(s); const float rs = rsqrtf(s * (1.f / D) + EPS);
#pragma unroll
    for (int j = 0; j < 32; ++j) r[lane + 64 * j] = v[j] * rs * g[lane + 64 * j];
}

extern "C" void kernel_launch(void* const* d_in, const int* in_sizes, int n_in, void* d_out, int out_size, void* d_ws, size_t ws_size, hipStream_t stream) {
    if (ws_size < WS_END) return;
    const float* x = (const float*)d_in[0]; const float* mem = (const float*)d_in[1]; const float* g_mix = (const float*)d_in[2]; const float* w_in = (const float*)d_in[3];
    const float* conv_w = (const float*)d_in[4]; const float* sinks = (const float*)d_in[5]; const float* w_ap = (const float*)d_in[6]; const float* w_cp = (const float*)d_in[7];
    const float* w_mo = (const float*)d_in[8]; const float* g_x = (const float*)d_in[9]; const float* g_mem = (const float*)d_in[10]; const float* w_xq = (const float*)d_in[11];
    const float* w_xkv = (const float*)d_in[12]; const float* w_xo = (const float*)d_in[13]; const float* g_ffn = (const float*)d_in[14]; const float* w_fi = (const float*)d_in[15];
    const float* w_fo = (const float*)d_in[16]; const float* g_fin = (const float*)d_in[17];
    char* ws = (char*)d_ws; float* out = (float*)d_out;
    float* ss0 = (float*)(ws + WS_SS); float* ss1 = ss0 + M; float* ss2 = ss1 + M; float* rope = (float*)(ws + WS_ROPE);
    bf16_t* memn = (bf16_t*)(ws + WS_MEMN); bf16_t* kx = (bf16_t*)(ws + WS_KX); bf16_t* vxt = (bf16_t*)(ws + WS_VXT);
    bf16_t* xb = (bf16_t*)(ws + WS_XB); bf16_t* q = (bf16_t*)(ws + WS_Q); bf16_t* k = (bf16_t*)(ws + WS_K); bf16_t* v = (bf16_t*)(ws + WS_V);
    bf16_t* cz = (bf16_t*)(ws + WS_CZ); bf16_t* gb = (bf16_t*)(ws + WS_GB); bf16_t* sa = (bf16_t*)(ws + WS_SA); bf16_t* sc = (bf16_t*)(ws + WS_SC);
    bf16_t* hb = (bf16_t*)(ws + WS_HB); bf16_t* merged = xb; bf16_t* xq = q; bf16_t* act = (bf16_t*)(ws + WS_ACT);
    float* T1 = out; float* H = out;
    (void)hipMemsetAsync(ss1, 0, 2 * M * sizeof(float), stream);
    k_prep<<<1024, 256, 0, stream>>>(x, mem, g_mem, xb, ss0, memn, rope);
    const dim3 blk(256);
    gemm_naive<<<dim3(512 / 64, M / 64), blk, 0, stream>>>(xb, D, w_in, INW, g_mix, EpiRope{q, 1024, 0, ss0, rope, QSCALE, 0});
    gemm_naive<<<dim3(128 / 64, M / 64), blk, 0, stream>>>(xb, D, w_in, INW, g_mix, EpiRope{k, 256, 1024, ss0, rope, 1.f, 0});
    gemm_naive<<<dim3(256 / 64, M / 64), blk, 0, stream>>>(xb, D, w_in, INW, g_mix, EpiPlain{v, 256, 1280, ss0, 0, 1.f, 0, 0});
    gemm_naive<<<dim3(1024 / 64, M / 64), blk, 0, stream>>>(xb, D, w_in, INW, g_mix, EpiMul{cz, ss0, 1024, 1536, 3584, 0});
    gemm_naive<<<dim3(1024 / 64, M / 64), blk, 0, stream>>>(xb, D, w_in, INW, g_mix, EpiPlain{gb, 1024, 2560, ss0, 0, 1.f, 0, 0});
    gemm_naive<<<dim3(2048 / 64, M / 64), blk, 0, stream>>>(xb, D, w_in, INW, g_mix, EpiPlain{sa, 2048, 4608, ss0, 1, 1.f, 0, 0});
    gemm_naive<<<dim3(2048 / 64, M / 64), blk, 0, stream>>>(xb, D, w_in, INW, g_mix, EpiPlain{sc, 2048, 6656, ss0, 1, 1.f, 0, 0});
    gemm_naive<<<dim3(512 / 64, MM / 64), blk, 0, stream>>>(memn, D, w_xkv, 2 * XW, nullptr, EpiPlain{kx, XW, 0, nullptr, 0, 1.f, 0, 0});
    gemm_naive<<<dim3(512 / 64, MM / 64), blk, 0, stream>>>(memn, D, w_xkv, 2 * XW, nullptr, EpiPlain{vxt, MM, XW, nullptr, 0, 1.f, 1, 0});
    k_swa<<<M * 16 / 4, 256, 0, stream>>>(q, k, v, sinks);
    k_conv<<<M * 1024 / 256, 256, 0, stream>>>(cz, gb, conv_w);
    gemm_naive<<<dim3(D / 64, M / 64), blk, 0, stream>>>(q, 1024, w_ap, D, nullptr, EpiT1{T1, sa});
    gemm_naive<<<dim3(D / 64, M / 64), blk, 0, stream>>>(gb, 1024, w_cp, D, nullptr, EpiMerged{T1, sc, merged});
    gemm_naive<<<dim3(D / 64, M / 64), blk, 0, stream>>>(merged, D, w_mo, D, nullptr, EpiRes{x, H, hb, ss1});
    gemm_naive<<<dim3(XW / 64, M / 64), blk, 0, stream>>>(hb, D, w_xq, XW, g_x, EpiPlain{xq, XW, 0, ss1, 0, XSCALE, 0, 0});
    k_xattn<<<M * 4 / 4, 256, 0, stream>>>(xq, kx, vxt);
    gemm_naive<<<dim3(D / 64, M / 64), blk, 0, stream>>>(xq, XW, w_xo, D, nullptr, EpiRes{H, H, hb, ss2});
    gemm_naive<<<dim3(FFN / 64, M / 64), blk, 0, stream>>>(hb, D, w_fi, 2 * FFN, g_ffn, EpiFfn{act, ss2});
    gemm_naive<<<dim3(D / 64, M / 64), blk, 0, stream>>>(act, FFN, w_fo, D, nullptr, EpiRes{H, H, nullptr, nullptr});
    k_final<<<M / 4, 256, 0, stream>>>(out, g_fin);
}
```

```cpp
#include <hip/hip_runtime.h>
#include <hip/hip_cooperative_groups.h>
#include <cstdio>
#include <cstdint>
namespace cg = cooperative_groups;
namespace pg8 {
#define PG8_LAS __attribute__((address_space(3)))
typedef unsigned short bf16_t;
typedef short bf16x8 __attribute__((ext_vector_type(8)));
typedef float f32x4 __attribute__((ext_vector_type(4)));
typedef unsigned u32x4 __attribute__((ext_vector_type(4)));
constexpr int BM = 256, BK = 64, HALF = 128, HTB = HALF * BK * 2  , STAGE_BYTES = 8 * HTB, NXCD = 8, WGM = 8;

__host__ __device__ __forceinline__ int lds_byte(int r, int c) { const int st = (r >> 4) * 2 + (c >> 5), rr = r & 15, cc = c & 31, ob = rr * 64 + cc * 2; return st * 1024 + (ob ^ (((ob >> 9) & 1) << 5)); }
__host__ __device__ __forceinline__ void stage_rc(int b, int& R, int& C) { const int st = b / 1024, sb = b % 1024, swz = sb ^ (((sb >> 9) & 1) << 5); R = (st >> 1) * 16 + swz / 64; C = (st & 1) * 32 + (swz % 64) / 2; }
__host__ __device__ __forceinline__ int perm32(int rho) { const int n = rho >> 4, i = rho & 15; return 8 * (i >> 2) + 4 * n + (i & 3); }

struct Unit { int pm, pn; };
struct Gemm { const bf16_t* A; const bf16_t* Bt; int M, N, K; };

struct StaticOrder {
    int nM, nN, nwg, G, c;
    __host__ __device__ void init(int M, int N, int G_, int c_) { nM = M / BM; nN = N / BM; nwg = nM * nN; G = G_; c = c_; }
    __host__ __device__ bool next(int i, Unit& u) const {
        const long L = (long)i * G + c; if (L >= nwg) return false;
        int wgid = (int)L; { const int q = nwg / NXCD, r = nwg % NXCD, xcd = wgid % NXCD, off = wgid / NXCD; wgid = (xcd < r ? xcd * (q + 1) : r * (q + 1) + (xcd - r) * q) + off; }
        const int nig = WGM * nN, gid = wgid / nig, fm = gid * WGM, gsz = (nM - fm) < WGM ? (nM - fm) : WGM;
        u.pm = fm + ((wgid % nig) % gsz); u.pn = (wgid % nig) / gsz; return true;
    }
    __device__ __forceinline__ void a_ready(const Unit&) const {}
    __device__ __forceinline__ void done(const Unit&) const {}
};

__device__ __forceinline__ unsigned cvt_pk_bf16(float lo, float hi) { unsigned r; asm volatile("v_cvt_pk_bf16_f32 %0, %1, %2" : "=v"(r) : "v"(lo), "v"(hi)); return r; }
typedef float f32x2 __attribute__((ext_vector_type(2)));
template <class Epi, class Sched, bool ALIGN_EPI = false, bool SP2 = false>
__device__ __forceinline__ void gemm_phase(PG8_LAS unsigned char* lds, const Gemm g, const Sched& S, const Epi& E) {
    const int tid = threadIdx.x, wid = __builtin_amdgcn_readfirstlane(tid >> 6), lane = tid & 63, wr = wid >> 2, wc = wid & 3, fr = lane & 15, fq = lane >> 4;
    const int K = g.K, nt = K / BK;
    unsigned voffA[2], voffB[2];
#pragma unroll
    for (int i = 0; i < 2; ++i) { int R, C; stage_rc(tid * 16 + i * 8192, R, C); const int Rb = Epi::PERM ? ((R & ~31) + perm32(R & 31)) : R;
        voffA[i] = (unsigned)(R * K + C) * 2u; voffB[i] = (unsigned)(Rb * K + C) * 2u; }
    const size_t kstep = (size_t)(BK * 2);
    const size_t hstep = (size_t)HALF * K * 2;
    const size_t tstep = 2 * hstep;
    const unsigned ldsw = (unsigned)wid * 1024u;
    const int aoff = lds_byte(wr * 64 + fr, fq * 8), boff = lds_byte(wc * 32 + fr, fq * 8);
#define PG8_SA(b, h) (((b) * 2 + (h)) * HTB)
#define PG8_SB(b, h) ((4 + (b) * 2 + (h)) * HTB)
#define PG8_STAGE(bufoff, gbase, voff) do { _Pragma("unroll") for (int _i = 0; _i < 2; ++_i) \
        __builtin_amdgcn_global_load_lds((const unsigned*)((const char*)(gbase) + (voff)[_i]), (PG8_LAS unsigned*)(lds + (bufoff) + ldsw + _i * 8192), 16, 0, 0); } while (0)
#define PG8_LDA(dst, b, h) do { _Pragma("unroll") for (int m = 0; m < 4; ++m) _Pragma("unroll") for (int k = 0; k < 2; ++k) dst[m][k] = *(const PG8_LAS bf16x8*)(lds + PG8_SA(b, h) + aoff + m * 2048 + k * 1024); } while (0)
#define PG8_LDB(dst, b, h) do { _Pragma("unroll") for (int n = 0; n < 2; ++n) _Pragma("unroll") for (int k = 0; k < 2; ++k) dst[n][k] = *(const PG8_LAS bf16x8*)(lds + PG8_SB(b, h) + boff + n * 2048 + k * 1024); } while (0)
#define PG8_MMA(ai, bj, At, Bt) do { __builtin_amdgcn_s_setprio(1); _Pragma("unroll") for (int m = 0; m < 4; ++m) _Pragma("unroll") for (int n = 0; n < 2; ++n) _Pragma("unroll") for (int k = 0; k < 2; ++k) \
        acc[ai][bj][m][n] = __builtin_amdgcn_mfma_f32_16x16x32_bf16(Bt[n][k], At[m][k], acc[ai][bj][m][n], 0, 0, 0); __builtin_amdgcn_s_setprio(0); } while (0)
#define PG8_WAIT_V(n) asm volatile("s_waitcnt vmcnt(" #n ")" ::: "memory")
#define PG8_WAIT_L(n) asm volatile("s_waitcnt lgkmcnt(" #n ")" ::: "memory")
#define PG8_BAR __builtin_amdgcn_s_barrier()
#define PG8_SCHED __builtin_amdgcn_sched_barrier(0)
    Unit cur, nxt; int ui = 0;
    if (!S.next(0, cur)) return;
    f32x4 acc[2][2][4][2];
#pragma unroll
    for (int a = 0; a < 2; ++a)
#pragma unroll
        for (int b = 0; b < 2; ++b)
#pragma unroll
            for (int m = 0; m < 4; ++m)
#pragma unroll
                for (int n = 0; n < 2; ++n) acc[a][b][m][n] = (f32x4){0.f, 0.f, 0.f, 0.f};
    bf16x8 At[4][2], B0[2][2], B1[2][2];
    const char* cA = (const char*)g.A + (size_t)cur.pm * tstep; const char* cB = (const char*)g.Bt + (size_t)cur.pn * tstep;
    S.a_ready(cur);
    if constexpr (SP2) {
        PG8_STAGE(PG8_SB(0, 0), cB, voffB); PG8_STAGE(PG8_SB(0, 1), cB + hstep, voffB); PG8_STAGE(PG8_SA(0, 0), cA, voffA); PG8_STAGE(PG8_SA(0, 1), cA + hstep, voffA);
        if (wr == 1) PG8_BAR;
        PG8_WAIT_V(2); PG8_BAR;
        PG8_STAGE(PG8_SB(1, 0), cB + kstep, voffB); PG8_STAGE(PG8_SA(1, 0), cA + kstep, voffA); PG8_STAGE(PG8_SB(1, 1), cB + hstep + kstep, voffB);
        PG8_WAIT_V(6); PG8_BAR;
    } else {
        PG8_STAGE(PG8_SB(0, 0), cB, voffB); PG8_STAGE(PG8_SA(0, 0), cA, voffA); PG8_STAGE(PG8_SB(0, 1), cB + hstep, voffB); PG8_STAGE(PG8_SA(0, 1), cA + hstep, voffA);
        if (wr == 1) PG8_BAR;
        PG8_WAIT_V(4); PG8_BAR;
        PG8_STAGE(PG8_SB(1, 0), cB + kstep, voffB); PG8_STAGE(PG8_SA(1, 0), cA + kstep, voffA); PG8_STAGE(PG8_SB(1, 1), cB + hstep + kstep, voffB);
        PG8_WAIT_V(6); PG8_BAR;
    }
    for (;;) {
        const bool has_next = S.next(ui + 1, nxt);
        const char* nA = has_next ? (const char*)g.A + (size_t)nxt.pm * tstep : cA; const char* nB = has_next ? (const char*)g.Bt + (size_t)nxt.pn * tstep : cB;
        for (int t = 0; t < nt; t += 2) {
            const bool last = (t == nt - 2);
            const char* a1 = cA + (size_t)(t + 1) * kstep;
            const char* a2 = last ? nA : cA + (size_t)(t + 2) * kstep; const char* b2 = last ? nB : cB + (size_t)(t + 2) * kstep;
            const char* a3 = a2 + kstep; const char* b3 = b2 + kstep;
            if (last && has_next) S.a_ready(nxt);
            if constexpr (SP2) {
            PG8_LDB(B0, 0, 0); PG8_LDB(B1, 0, 1); PG8_SCHED; PG8_LDA(At, 0, 0); PG8_STAGE(PG8_SA(1, 1), a1 + hstep, voffA);
            PG8_WAIT_V(8); PG8_WAIT_L(0); PG8_BAR; PG8_MMA(0, 0, At, B0); PG8_MMA(0, 1, At, B1); PG8_BAR; PG8_SCHED;
            PG8_LDA(At, 0, 1); PG8_STAGE(PG8_SB(0, 0), b2, voffB); PG8_STAGE(PG8_SB(0, 1), b2 + hstep, voffB); PG8_STAGE(PG8_SA(0, 0), a2, voffA);
            PG8_WAIT_V(8); PG8_WAIT_L(0); PG8_BAR; PG8_MMA(1, 0, At, B0); PG8_MMA(1, 1, At, B1); PG8_BAR; PG8_SCHED;
            PG8_LDB(B0, 1, 0); PG8_LDB(B1, 1, 1); PG8_SCHED; PG8_LDA(At, 1, 0); PG8_STAGE(PG8_SA(0, 1), a2 + hstep, voffA);
            PG8_WAIT_V(8); PG8_WAIT_L(0); PG8_BAR; PG8_MMA(0, 0, At, B0); PG8_MMA(0, 1, At, B1); PG8_BAR; PG8_SCHED;
            PG8_LDA(At, 1, 1); PG8_STAGE(PG8_SB(1, 0), b3, voffB); PG8_STAGE(PG8_SB(1, 1), b3 + hstep, voffB); PG8_STAGE(PG8_SA(1, 0), a3, voffA);
            PG8_WAIT_V(8); PG8_WAIT_L(0); PG8_BAR; PG8_MMA(1, 0, At, B0); PG8_MMA(1, 1, At, B1); PG8_BAR; PG8_SCHED;
            } else {
            PG8_LDB(B0, 0, 0); PG8_SCHED; PG8_LDA(At, 0, 0); PG8_STAGE(PG8_SA(1, 1), a1 + hstep, voffA);
            PG8_WAIT_L(8); PG8_BAR; PG8_WAIT_L(0); PG8_MMA(0, 0, At, B0); PG8_BAR; PG8_SCHED;
            PG8_LDB(B1, 0, 1); PG8_STAGE(PG8_SB(0, 0), b2, voffB);
            PG8_BAR; PG8_WAIT_L(0); PG8_MMA(0, 1, At, B1); PG8_BAR;
            PG8_LDA(At, 0, 1); PG8_STAGE(PG8_SA(0, 0), a2, voffA);
            PG8_BAR; PG8_WAIT_L(0); PG8_MMA(1, 0, At, B0); PG8_BAR; PG8_SCHED;
            PG8_STAGE(PG8_SB(0, 1), b2 + hstep, voffB);
            PG8_WAIT_V(6); PG8_BAR; PG8_MMA(1, 1, At, B1); PG8_BAR;
            PG8_LDB(B0, 1, 0); PG8_SCHED; PG8_LDA(At, 1, 0); PG8_STAGE(PG8_SA(0, 1), a2 + hstep, voffA);
            PG8_WAIT_L(8); PG8_BAR; PG8_WAIT_L(0); PG8_MMA(0, 0, At, B0); PG8_BAR; PG8_SCHED;
            PG8_LDB(B1, 1, 1); PG8_STAGE(PG8_SB(1, 0), b3, voffB);
            PG8_BAR; PG8_WAIT_L(0); PG8_MMA(0, 1, At, B1); PG8_BAR;
            PG8_LDA(At, 1, 1); PG8_STAGE(PG8_SA(1, 0), a3, voffA);
            PG8_BAR; PG8_WAIT_L(0); PG8_MMA(1, 0, At, B0); PG8_BAR; PG8_SCHED;
            PG8_STAGE(PG8_SB(1, 1), b3 + hstep, voffB);
            PG8_WAIT_V(6); PG8_BAR; PG8_MMA(1, 1, At, B1); PG8_BAR;
            }
        }
        if constexpr (ALIGN_EPI) { if (wr == 0) PG8_BAR; }
        if constexpr (!Epi::AFTER_DRAIN) { E(acc, cur, wr, wc, fr, fq); S.done(cur); }
        if (!has_next) break;
#pragma unroll
        for (int a = 0; a < 2; ++a)
#pragma unroll
            for (int b = 0; b < 2; ++b)
#pragma unroll
                for (int m = 0; m < 4; ++m)
#pragma unroll
                    for (int n = 0; n < 2; ++n) acc[a][b][m][n] = (f32x4){0.f, 0.f, 0.f, 0.f};
        cur = nxt; cA = nA; cB = nB; ++ui;
        if constexpr (ALIGN_EPI) { if (wr == 1) PG8_BAR; }
    }
    PG8_WAIT_V(0);
    if constexpr (!ALIGN_EPI) { if (wr == 0) PG8_BAR; }
    PG8_BAR;
    if constexpr (Epi::AFTER_DRAIN) { E.fused(acc, cur, wr, wc, fr, fq, lds, wid, lane); S.done(cur); }
#undef PG8_SA
#undef PG8_SB
#undef PG8_STAGE
#undef PG8_LDA
#undef PG8_LDB
#undef PG8_MMA
#undef PG8_WAIT_V
#undef PG8_WAIT_L
#undef PG8_BAR
#undef PG8_SCHED
}
constexpr float LOG2E = 1.4426950408889634f;
constexpr float QSCALE = 0.125f * LOG2E;
constexpr float XSCALE = 0.08838834764831845f * LOG2E;
typedef unsigned u32x2 __attribute__((ext_vector_type(2)));
__device__ __forceinline__ float rstd_of(const float* ss, int row) { return __builtin_amdgcn_rsqf(ss[row] * (1.0f / 2048.0f) + 1e-6f); }
__device__ __forceinline__ f32x4 sigmoid4(f32x4 v) { f32x4 o;
#pragma unroll
    for (int i = 0; i < 4; ++i) o[i] = __builtin_amdgcn_rcpf(1.0f + __builtin_amdgcn_exp2f(-LOG2E * v[i]));
    return o; }
__device__ __forceinline__ u32x4 pack8(f32x4 a, f32x4 b) { u32x4 w; w.x = cvt_pk_bf16(a[0], a[1]); w.y = cvt_pk_bf16(a[2], a[3]); w.z = cvt_pk_bf16(b[0], b[1]); w.w = cvt_pk_bf16(b[2], b[3]); return w; }
__device__ __forceinline__ void unpack8(u32x4 w, f32x4& a, f32x4& b) {
    a[0] = __uint_as_float(w.x << 16); a[1] = __uint_as_float(w.x & 0xffff0000u); a[2] = __uint_as_float(w.y << 16); a[3] = __uint_as_float(w.y & 0xffff0000u);
    b[0] = __uint_as_float(w.z << 16); b[1] = __uint_as_float(w.z & 0xffff0000u); b[2] = __uint_as_float(w.w << 16); b[3] = __uint_as_float(w.w & 0xffff0000u); }

struct EpiIn {
    static constexpr bool PERM = true, AFTER_DRAIN = false;
    bf16_t *q, *k, *v, *cz, *gb, *sa, *sc; const float* ss; const float* rope;
    __device__ __forceinline__ void operator()(const f32x4 (&acc)[2][2][4][2], const Unit& u, int wr, int wc, int fr, int fq) const {
        const int row0 = u.pm * BM + wr * 64 + fr, pn = u.pn, cl = wc * 32 + 8 * fq;
        if (pn < 5) {
            bf16_t* base = pn < 4 ? q : k; const int ld = pn < 4 ? 1024 : 256, hbase = pn < 4 ? pn * 4 : 0; const float scale = pn < 4 ? QSCALE : 1.0f;
            const int jj = 4 * (wc & 1) + fq;
#pragma unroll
            for (int ai = 0; ai < 2; ++ai)
#pragma unroll
                for (int m = 0; m < 4; ++m) { const int row = row0 + ai * HALF + m * 16, t = row & 4095; const float r = rstd_of(ss, row) ;
                    const f32x4 cs = *(const f32x4*)(rope + t * 32 + 4 * jj), sn = *(const f32x4*)(rope + 131072 + t * 32 + 4 * jj);
#pragma unroll
                    for (int bj = 0; bj < 2; ++bj) { const f32x4 x1 = acc[ai][bj][m][0] * r, x2 = acc[ai][bj][m][1] * r;
                        const f32x4 o1 = (x1 * cs - x2 * sn) * scale, o2 = (x2 * cs + x1 * sn) * scale;
                        bf16_t* p = base + (size_t)row * ld + (hbase + 2 * bj + (wc >> 1)) * 64 + 4 * jj;
                        u32x2 w1, w2; w1.x = cvt_pk_bf16(o1[0], o1[1]); w1.y = cvt_pk_bf16(o1[2], o1[3]); w2.x = cvt_pk_bf16(o2[0], o2[1]); w2.y = cvt_pk_bf16(o2[2], o2[3]);
                        *(u32x2*)p = w1; *(u32x2*)(p + 32) = w2; } }
        } else if (pn >= 6 && pn < 14) {
            bf16_t* base = cz + (pn - 6) * 128 + cl;
#pragma unroll
            for (int ai = 0; ai < 2; ++ai)
#pragma unroll
                for (int m = 0; m < 4; ++m) { const int row = row0 + ai * HALF + m * 16; const float r = rstd_of(ss, row), r2 = r * r;
                    *(u32x4*)(base + (size_t)row * 1024) = pack8(acc[ai][0][m][0] * acc[ai][1][m][0] * r2, acc[ai][0][m][1] * acc[ai][1][m][1] * r2); }
        } else {
            bf16_t* base; int ld; bool sig;
            if (pn == 5) { base = v; ld = 256; sig = false; } else if (pn < 18) { base = gb + (pn - 14) * 256; ld = 1024; sig = false; }
            else if (pn < 26) { base = sa + (pn - 18) * 256; ld = 2048; sig = true; } else { base = sc + (pn - 26) * 256; ld = 2048; sig = true; }
#pragma unroll
            for (int ai = 0; ai < 2; ++ai)
#pragma unroll
                for (int m = 0; m < 4; ++m) { const int row = row0 + ai * HALF + m * 16; const float r = rstd_of(ss, row);
#pragma unroll
                    for (int bj = 0; bj < 2; ++bj) { f32x4 v0 = acc[ai][bj][m][0] * r, v1 = acc[ai][bj][m][1] * r; if (sig) { v0 = sigmoid4(v0); v1 = sigmoid4(v1); }
                        *(u32x4*)(base + (size_t)row * ld + bj * HALF + cl) = pack8(v0, v1); } }
        }
    }
};
struct EpiScale {
    static constexpr bool PERM = true, AFTER_DRAIN = false;
    bf16_t* O; const float* ss; int ldc; float scale;
    __device__ __forceinline__ void operator()(const f32x4 (&acc)[2][2][4][2], const Unit& u, int wr, int wc, int fr, int fq) const {
        const int row0 = u.pm * BM + wr * 64 + fr, col0 = u.pn * BM + wc * 32 + 8 * fq;
#pragma unroll
        for (int ai = 0; ai < 2; ++ai)
#pragma unroll
            for (int m = 0; m < 4; ++m) { const int row = row0 + ai * HALF + m * 16; const float r = (ss ? rstd_of(ss, row) : 1.0f) * scale;
#pragma unroll
                for (int bj = 0; bj < 2; ++bj) *(u32x4*)(O + (size_t)row * ldc + col0 + bj * HALF) = pack8(acc[ai][bj][m][0] * r, acc[ai][bj][m][1] * r); }
    }
};
struct EpiFfn {
    static constexpr bool PERM = true, AFTER_DRAIN = false;
    bf16_t* O; const float* ss;
    __device__ __forceinline__ void operator()(const f32x4 (&acc)[2][2][4][2], const Unit& u, int wr, int wc, int fr, int fq) const {
        const int row0 = u.pm * BM + wr * 64 + fr, col0 = u.pn * HALF + wc * 32 + 8 * fq;
#pragma unroll
        for (int ai = 0; ai < 2; ++ai)
#pragma unroll
            for (int m = 0; m < 4; ++m) { const int row = row0 + ai * HALF + m * 16; const float r = rstd_of(ss, row);
                const f32x4 g0 = acc[ai][0][m][0] * r, g1 = acc[ai][0][m][1] * r, u0 = acc[ai][1][m][0] * r, u1 = acc[ai][1][m][1] * r;
                *(u32x4*)(O + (size_t)row * 5632 + col0) = pack8(g0 * sigmoid4(g0) * u0, g1 * sigmoid4(g1) * u1); }
    }
};
struct EpiT1 {
    static constexpr bool PERM = true, AFTER_DRAIN = false;
    float* T1; const bf16_t* sa;
    __device__ __forceinline__ void operator()(const f32x4 (&acc)[2][2][4][2], const Unit& u, int wr, int wc, int fr, int fq) const {
        const int row0 = u.pm * BM + wr * 64 + fr, col0 = u.pn * BM + wc * 32 + 8 * fq;
#pragma unroll
        for (int ai = 0; ai < 2; ++ai)
#pragma unroll
            for (int m = 0; m < 4; ++m) { const size_t off = (size_t)(row0 + ai * HALF + m * 16) * 2048 + col0;
#pragma unroll
                for (int bj = 0; bj < 2; ++bj) { f32x4 g0, g1; unpack8(*(const u32x4*)(sa + off + bj * HALF), g0, g1);
                    *(f32x4*)(T1 + off + bj * HALF) = g0 * acc[ai][bj][m][0]; *(f32x4*)(T1 + off + bj * HALF + 4) = g1 * acc[ai][bj][m][1]; } }
    }
};
struct EpiMerged {
    static constexpr bool PERM = true, AFTER_DRAIN = false;
    const float* T1; const bf16_t* sc; bf16_t* O;
    __device__ __forceinline__ void operator()(const f32x4 (&acc)[2][2][4][2], const Unit& u, int wr, int wc, int fr, int fq) const {
        const int row0 = u.pm * BM + wr * 64 + fr, col0 = u.pn * BM + wc * 32 + 8 * fq;
#pragma unroll
        for (int ai = 0; ai < 2; ++ai)
#pragma unroll
            for (int m = 0; m < 4; ++m) { const size_t off = (size_t)(row0 + ai * HALF + m * 16) * 2048 + col0;
#pragma unroll
                for (int bj = 0; bj < 2; ++bj) { f32x4 g0, g1; unpack8(*(const u32x4*)(sc + off + bj * HALF), g0, g1);
                    const f32x4 t0 = *(const f32x4*)(T1 + off + bj * HALF), t1 = *(const f32x4*)(T1 + off + bj * HALF + 4);
                    *(u32x4*)(O + off + bj * HALF) = pack8(t0 + g0 * acc[ai][bj][m][0], t1 + g1 * acc[ai][bj][m][1]); } }
    }
};
struct EpiRes {
    static constexpr bool PERM = true, AFTER_DRAIN = false;
    const float* base; float* out; bf16_t* ob; float* ss;
    __device__ __forceinline__ void operator()(const f32x4 (&acc)[2][2][4][2], const Unit& u, int wr, int wc, int fr, int fq) const {
        const int row0 = u.pm * BM + wr * 64 + fr, col0 = u.pn * BM + wc * 32 + 8 * fq;
#pragma unroll
        for (int ai = 0; ai < 2; ++ai)
#pragma unroll
            for (int m = 0; m < 4; ++m) { const int row = row0 + ai * HALF + m * 16; const size_t off = (size_t)row * 2048 + col0; float s = 0.f;
#pragma unroll
                for (int bj = 0; bj < 2; ++bj) { const f32x4 h0 = *(const f32x4*)(base + off + bj * HALF) + acc[ai][bj][m][0], h1 = *(const f32x4*)(base + off + bj * HALF + 4) + acc[ai][bj][m][1];
                    *(f32x4*)(out + off + bj * HALF) = h0; *(f32x4*)(out + off + bj * HALF + 4) = h1;
                    if (ob) *(u32x4*)(ob + off + bj * HALF) = pack8(h0, h1);
                    s += (h0[0] * h0[0] + h0[1] * h0[1]) + (h0[2] * h0[2] + h0[3] * h0[3]) + (h1[0] * h1[0] + h1[1] * h1[1]) + (h1[2] * h1[2] + h1[3] * h1[3]); }
                if (ss) { s += __shfl_xor(s, 16); s += __shfl_xor(s, 32); if (fq == 0) atomicAdd(ss + row, s); } }
    }
};
}

#define LAS __attribute__((address_space(3)))
typedef unsigned short bf16;
typedef unsigned u32x4 __attribute__((ext_vector_type(4)));
typedef unsigned u32x2 __attribute__((ext_vector_type(2)));
typedef float f32x4 __attribute__((ext_vector_type(4)));
typedef float f32x16 __attribute__((ext_vector_type(16)));
typedef short bf16x8 __attribute__((ext_vector_type(8)));
typedef short s16x4 __attribute__((ext_vector_type(4)));
constexpr int NWAVES = 8, NTHREADS = 512;
constexpr int D = 2048, SEQ = 4096, M = 16384, MEMT = 256, MM = 1024, INW = 8704, FFN = 5632, XW = 512;
constexpr float EPS = 1e-6f;
constexpr float LOG2E = 1.4426950408889634f;
constexpr size_t MiB = 1u << 20;
constexpr size_t WS_SS = 0;
constexpr size_t WS_ROPE = 1 * MiB;
constexpr size_t WS_MEMN = 2 * MiB;
constexpr size_t WS_KV = 6 * MiB;
constexpr size_t WS_W = 8 * MiB;
constexpr size_t WS_WIN = WS_W;
constexpr size_t WS_WFI = WS_WIN + 34 * MiB;
constexpr size_t WS_WFO = WS_WFI + 44 * MiB;
constexpr size_t WS_WMO = WS_WFO + 22 * MiB;
constexpr size_t WS_WAP = WS_WMO + 8 * MiB;
constexpr size_t WS_WCP = WS_WAP + 4 * MiB;
constexpr size_t WS_WXQ = WS_WCP + 4 * MiB;
constexpr size_t WS_WKV = WS_WXQ + 2 * MiB;
constexpr size_t WS_WXO = WS_WKV + 4 * MiB;
constexpr size_t WS_ACT0 = WS_WXO + 2 * MiB;
static_assert(WS_ACT0 == 132 * MiB, "ws map");
constexpr size_t WS_XB = WS_ACT0;
constexpr size_t WS_Q = WS_XB + 64 * MiB;
constexpr size_t WS_K = WS_Q + 32 * MiB;
constexpr size_t WS_V = WS_K + 8 * MiB;
constexpr size_t WS_CZ = WS_V + 8 * MiB;
constexpr size_t WS_GB = WS_CZ + 32 * MiB;
constexpr size_t WS_SA = WS_GB + 32 * MiB;
constexpr size_t WS_SC = WS_SA + 64 * MiB;
constexpr size_t WS_HB = WS_SC + 64 * MiB;
constexpr size_t WS_ACT = WS_CZ;
constexpr size_t WS_END = WS_HB + 64 * MiB;
constexpr int LDS_BYTES = 147456;

__device__ __forceinline__ float wave_sum(float v) {
#pragma unroll
    for (int o = 1; o < 64; o <<= 1) v += __shfl_xor(v, o);
    return v;
}
__device__ __forceinline__ unsigned f2bf(float f) { unsigned u = __builtin_bit_cast(unsigned, f); return (u + 0x7fffu + ((u >> 16) & 1u)) >> 16; }
__device__ __forceinline__ unsigned pk2(float lo, float hi) { return f2bf(lo) | (f2bf(hi) << 16); }
__device__ __forceinline__ float bflo(unsigned w) { return __uint_as_float(w << 16); }
__device__ __forceinline__ float bfhi(unsigned w) { return __uint_as_float(w & 0xffff0000u); }
__device__ __forceinline__ int crow(int r, int hi) { return (r & 3) + 8 * (r >> 2) + 4 * hi; }
typedef short v4i16_t __attribute__((ext_vector_type(4)));
__device__ __forceinline__ s16x4 vtr(const LAS unsigned char* p) { return __builtin_bit_cast(s16x4, __builtin_amdgcn_ds_read_tr16_b64_v4i16((LAS v4i16_t*)p)); }
#define MFMA32(a, b, c) __builtin_amdgcn_mfma_f32_32x32x16_bf16((a), (b), (c), 0, 0, 0)

__device__ __forceinline__ int src_in(int n) {
    if (n < 1280) { const int p = n & 63; return (n & ~63) + (p & 3) + 4 * (p >> 3) + 32 * ((p >> 2) & 1); }
    if (n < 1536) return n;
    if (n < 3584) { const int it = (n - 1536) >> 8, c = (n - 1536) & 255; return c < 128 ? 1536 + 128 * it + c : 3584 + 128 * it + (c - 128); }
    if (n < 4608) return 2560 + (n - 3584);
    return n;
}
__device__ __forceinline__ int src_ffn(int n) { const int pn = n >> 8, c = n & 255; return c < 128 ? 128 * pn + c : FFN + 128 * pn + (c - 128); }
template <int MAP> __device__ __forceinline__ void p0_transpose_item(const float* W, int ldw, int K, int Np, const float* g, bf16* WT, LAS float* scr, int item, int lane) {
    const int nblk = Np / 32, kb = item / nblk, nb = item % nblk, k0 = 64 * kb, n0 = 32 * nb;
    const int nn = n0 + (lane & 31), sc = MAP == 1 ? src_in(nn) : (MAP == 2 ? src_ffn(nn) : nn);
#pragma unroll 8
    for (int i = 0; i < 32; ++i) { const int kk = 2 * i + (lane >> 5); float w = W[(size_t)(k0 + kk) * ldw + sc]; if (g) w *= g[k0 + kk]; scr[kk * 33 + (lane & 31)] = w; }
    asm volatile("s_waitcnt lgkmcnt(0)" ::: "memory");
    const int c = lane & 7;
#pragma unroll
    for (int j = 0; j < 4; ++j) { const int n = (lane >> 3) + 8 * j; const LAS float* s = scr + (8 * c) * 33 + n;
        u32x4 o; o.x = pk2(s[0 * 33], s[1 * 33]); o.y = pk2(s[2 * 33], s[3 * 33]); o.z = pk2(s[4 * 33], s[5 * 33]); o.w = pk2(s[6 * 33], s[7 * 33]);
        *(u32x4*)(WT + (size_t)(n0 + n) * K + k0 + 8 * c) = o; }
    asm volatile("s_waitcnt lgkmcnt(0)" ::: "memory");
}

struct Args { const float* in[18]; float* out; unsigned char* ws; int ph_lo, ph_hi; };

__device__ __forceinline__ void p0_prologue(const Args& a, LAS unsigned char* lds, int gw, int NGW, int wave, int lane) {
    unsigned char* ws = a.ws;
    LAS float* scr = (LAS float*)(lds + wave * 8448);
    constexpr int I_IN = (D / 64) * (INW / 32), I_FI = (D / 64) * (2 * FFN / 32), I_FO = (FFN / 64) * (D / 32), I_MO = (D / 64) * (D / 32), I_AP = (1024 / 64) * (D / 32), I_CP = I_AP,
                  I_XQ = (D / 64) * (XW / 32), I_KV = (D / 64) * (1024 / 32), I_XO = (XW / 64) * (D / 32);
    constexpr int NITEMS = I_IN + I_FI + I_FO + I_MO + I_AP + I_CP + I_XQ + I_KV + I_XO;
    for (int it = gw; it < NITEMS; it += NGW) {
        int r = it;
        if (r < I_IN) { p0_transpose_item<1>(a.in[3], INW, D, INW, a.in[2], (bf16*)(ws + WS_WIN), scr, r, lane); continue; } r -= I_IN;
        if (r < I_FI) { p0_transpose_item<2>(a.in[15], 2 * FFN, D, 2 * FFN, a.in[14], (bf16*)(ws + WS_WFI), scr, r, lane); continue; } r -= I_FI;
        if (r < I_FO) { p0_transpose_item<0>(a.in[16], D, FFN, D, nullptr, (bf16*)(ws + WS_WFO), scr, r, lane); continue; } r -= I_FO;
        if (r < I_MO) { p0_transpose_item<0>(a.in[8], D, D, D, nullptr, (bf16*)(ws + WS_WMO), scr, r, lane); continue; } r -= I_MO;
        if (r < I_AP) { p0_transpose_item<0>(a.in[6], D, 1024, D, nullptr, (bf16*)(ws + WS_WAP), scr, r, lane); continue; } r -= I_AP;
        if (r < I_CP) { p0_transpose_item<0>(a.in[7], D, 1024, D, nullptr, (bf16*)(ws + WS_WCP), scr, r, lane); continue; } r -= I_CP;
        if (r < I_XQ) { p0_transpose_item<0>(a.in[11], XW, D, XW, a.in[9], (bf16*)(ws + WS_WXQ), scr, r, lane); continue; } r -= I_XQ;
        if (r < I_KV) { p0_transpose_item<0>(a.in[12], 1024, D, 1024, nullptr, (bf16*)(ws + WS_WKV), scr, r, lane); continue; } r -= I_KV;
        p0_transpose_item<0>(a.in[13], D, XW, D, nullptr, (bf16*)(ws + WS_WXO), scr, r, lane);
    }
    const float* x = a.in[0]; bf16* xb = (bf16*)(ws + WS_XB); float* ss0 = (float*)(ws + WS_SS);
    for (int m = gw; m < M; m += NGW) {
        const f32x4* xr = (const f32x4*)(x + (size_t)m * D) + lane; u32x2* o = (u32x2*)(xb + (size_t)m * D) + lane; float s = 0.f;
#pragma unroll
        for (int j = 0; j < 8; ++j) { const f32x4 v = xr[64 * j]; s += (v.x * v.x + v.y * v.y) + (v.z * v.z + v.w * v.w); u32x2 w; w.x = pk2(v.x, v.y); w.y = pk2(v.z, v.w); o[64 * j] = w; }
        s = wave_sum(s); if (lane == 0) ss0[m] = s;
    }
    const float* mem = a.in[1]; const float* gm = a.in[10]; bf16* memn = (bf16*)(ws + WS_MEMN);
    for (int m = gw; m < MM; m += NGW) {
        const f32x4* xr = (const f32x4*)(mem + (size_t)m * D) + lane; const f32x4* gr = (const f32x4*)gm + lane; u32x2* o = (u32x2*)(memn + (size_t)m * D) + lane; f32x4 v[8]; float s = 0.f;
#pragma unroll
        for (int j = 0; j < 8; ++j) { v[j] = xr[64 * j]; s += (v[j].x * v[j].x + v[j].y * v[j].y) + (v[j].z * v[j].z + v[j].w * v[j].w); }
        const float rs = __builtin_amdgcn_rsqf(wave_sum(s) * (1.0f / D) + EPS);
#pragma unroll
        for (int j = 0; j < 8; ++j) { const f32x4 g = gr[64 * j]; u32x2 w; w.x = pk2(v[j].x * rs * g.x, v[j].y * rs * g.y); w.y = pk2(v[j].z * rs * g.z, v[j].w * rs * g.w); o[64 * j] = w; }
    }
    float* rope = (float*)(ws + WS_ROPE);
    for (int e = gw * 64 + lane; e < 4096 * 32; e += NGW * 64) {
        const int t = e >> 5, i = e & 31;
        const float inv = (float)exp(-(double)i / 32.0 * 9.210340371976184);
        const float ang = (float)t * inv;
        double rev = (double)ang * 0.15915494309189535; rev -= floor(rev + 0.5);
        const double xr = rev * 6.283185307179586, x2 = xr * xr;
        double sn = 0.0, cs = 0.0, ts = xr, tc = 1.0;
#pragma unroll
        for (int n = 0; n < 14; ++n) { cs += tc; sn += ts; tc *= -x2 / (double)((2 * n + 1) * (2 * n + 2)); ts *= -x2 / (double)((2 * n + 2) * (2 * n + 3)); }
        rope[e] = (float)cs; rope[4096 * 32 + e] = (float)sn;
    }
}

constexpr int SWA_KRS = 144, SWA_VOFF = 256 * SWA_KRS, SWA_VIMG = 256 * 64;
__device__ __forceinline__ void swa_unit(LAS unsigned char* lds, int unit, bf16* Q, const bf16* Kg, const bf16* Vg, const float* sinks) {
    const int tid = threadIdx.x, lane = tid & 63, wid = __builtin_amdgcn_readfirstlane(tid >> 6), r32 = lane & 31, hi = lane >> 5;
    const int hk = unit & 3, nb = (unit >> 2) & 31, b = unit >> 7;
    const int tok0 = b * SEQ + nb * 128;
#pragma unroll
    for (int i = 0; i < 4; ++i) {
        const int c = tid + NTHREADS * i, key = c >> 3, ch = c & 7;
        u32x4 kv = (u32x4){0u, 0u, 0u, 0u}, vv = (u32x4){0u, 0u, 0u, 0u};
        if (nb > 0 || key >= 128) { const size_t go = (size_t)(tok0 - 128 + key) * 256 + hk * 64 + ch * 8; kv = *(const u32x4*)(Kg + go); vv = *(const u32x4*)(Vg + go); }
        *(LAS u32x4*)(lds + key * SWA_KRS + ch * 16) = kv;
        *(LAS u32x4*)(lds + SWA_VOFF + (ch >> 2) * SWA_VIMG + key * 64 + (ch & 3) * 16) = vv;
    }
    __syncthreads();
    const int g = wid >> 1, rh = wid & 1, head = hk * 4 + g;
    const float sink = sinks[head] * LOG2E;
    const float NEG = -__builtin_inff();
    const int q4 = (lane & 15) >> 2, p4 = lane & 3, dh = (lane >> 4) & 1;
    for (int sb = 0; sb < 2; ++sb) {
        const int kb0 = 2 * rh + sb;
        bf16* qp = Q + (size_t)(tok0 + 32 * kb0 + r32) * 1024 + head * 64;
        bf16x8 qf[4];
#pragma unroll
        for (int ds = 0; ds < 4; ++ds) qf[ds] = *(const bf16x8*)(qp + 16 * ds + 8 * hi);
        f32x16 s[5];
#pragma unroll
        for (int jb = 0; jb < 5; ++jb) {
            const LAS unsigned char* kp = lds + (32 * (kb0 + jb) + r32) * SWA_KRS + hi * 16;
            f32x16 c = {};
#pragma unroll
            for (int ds = 0; ds < 4; ++ds) c = MFMA32(*(const LAS bf16x8*)(kp + ds * 32), qf[ds], c);
            s[jb] = c;
        }
#pragma unroll
        for (int r = 0; r < 16; ++r) { const int kk = crow(r, hi); if (kk <= r32) s[0][r] = NEG; if (kk > r32) s[4][r] = NEG; }
        if (nb == 0) {
#pragma unroll
            for (int jb = 0; jb < 4; ++jb) if (kb0 + jb < 4) {
#pragma unroll
                for (int r = 0; r < 16; ++r) s[jb][r] = NEG; }
        }
        float mx = sink;
#pragma unroll
        for (int jb = 0; jb < 5; ++jb)
#pragma unroll
            for (int r = 0; r < 16; ++r) mx = fmaxf(mx, s[jb][r]);
        mx = fmaxf(mx, __shfl_xor(mx, 32));
        float l = 0.f;
#pragma unroll
        for (int jb = 0; jb < 5; ++jb)
#pragma unroll
            for (int r = 0; r < 16; ++r) { const float p = __builtin_amdgcn_exp2f(s[jb][r] - mx); s[jb][r] = p; l += p; }
        l += __shfl_xor(l, 32); l += __builtin_amdgcn_exp2f(sink - mx);
        bf16x8 pf[5][2];
#pragma unroll
        for (int jb = 0; jb < 5; ++jb)
#pragma unroll
            for (int s2 = 0; s2 < 2; ++s2) { u32x4 w; w.x = pg8::cvt_pk_bf16(s[jb][8 * s2 + 0], s[jb][8 * s2 + 1]); w.y = pg8::cvt_pk_bf16(s[jb][8 * s2 + 2], s[jb][8 * s2 + 3]);
                w.z = pg8::cvt_pk_bf16(s[jb][8 * s2 + 4], s[jb][8 * s2 + 5]); w.w = pg8::cvt_pk_bf16(s[jb][8 * s2 + 6], s[jb][8 * s2 + 7]); pf[jb][s2] = __builtin_bit_cast(bf16x8, w); }
        const float inv = 1.0f / l;
#pragma unroll
        for (int db = 0; db < 2; ++db) {
            const LAS unsigned char* vp = lds + SWA_VOFF + db * SWA_VIMG + (32 * kb0 + 4 * hi + q4) * 64 + dh * 32 + p4 * 8;
            f32x16 o = {};
#pragma unroll
            for (int jb = 0; jb < 5; ++jb)
#pragma unroll
                for (int s2 = 0; s2 < 2; ++s2) { const s16x4 lo = vtr(vp + (32 * jb + 16 * s2) * 64), h8 = vtr(vp + (32 * jb + 16 * s2 + 8) * 64);
                    const bf16x8 vf = (bf16x8){lo[0], lo[1], lo[2], lo[3], h8[0], h8[1], h8[2], h8[3]};
                    o = MFMA32(vf, pf[jb][s2], o); }
#pragma unroll
            for (int gi = 0; gi < 4; ++gi) { u32x2 w; w.x = pg8::cvt_pk_bf16(o[4 * gi] * inv, o[4 * gi + 1] * inv); w.y = pg8::cvt_pk_bf16(o[4 * gi + 2] * inv, o[4 * gi + 3] * inv);
                *(u32x2*)(qp + 32 * db + 8 * gi + 4 * hi) = w; }
        }
    }
    __syncthreads();
}
__device__ __forceinline__ void conv_items(const bf16* cz, bf16* gb, const float* w, int gtid, int ngt) {
    for (int e = gtid; e < M * 128; e += ngt) {
        const int m = e >> 7, c = (e & 127) * 8, t = m & (SEQ - 1); const size_t off = (size_t)m * 1024 + c;
        const u32x4 z0 = *(const u32x4*)(cz + off), gv = *(const u32x4*)(gb + off);
        u32x4 z1 = (u32x4){0u, 0u, 0u, 0u}, z2 = (u32x4){0u, 0u, 0u, 0u};
        if (t >= 1) z1 = *(const u32x4*)(cz + off - 1024);
        if (t >= 2) z2 = *(const u32x4*)(cz + off - 2048);
        const f32x4 w0a = *(const f32x4*)(w + c), w0b = *(const f32x4*)(w + c + 4), w1a = *(const f32x4*)(w + 1024 + c), w1b = *(const f32x4*)(w + 1024 + c + 4), w2a = *(const f32x4*)(w + 2048 + c), w2b = *(const f32x4*)(w + 2048 + c + 4);
        u32x4 o;
#pragma unroll
        for (int j = 0; j < 4; ++j) {
            const float wl0 = j < 2 ? w0a[2 * j] : w0b[2 * j - 4], wh0 = j < 2 ? w0a[2 * j + 1] : w0b[2 * j - 3];
            const float wl1 = j < 2 ? w1a[2 * j] : w1b[2 * j - 4], wh1 = j < 2 ? w1a[2 * j + 1] : w1b[2 * j - 3];
            const float wl2 = j < 2 ? w2a[2 * j] : w2b[2 * j - 4], wh2 = j < 2 ? w2a[2 * j + 1] : w2b[2 * j - 3];
            const float lo = bflo(gv[j]) * (wl0 * bflo(z2[j]) + wl1 * bflo(z1[j]) + wl2 * bflo(z0[j]));
            const float hh = bfhi(gv[j]) * (wh0 * bfhi(z2[j]) + wh1 * bfhi(z1[j]) + wh2 * bfhi(z0[j]));
            o[j] = pg8::cvt_pk_bf16(lo, hh);
        }
        *(u32x4*)(gb + off) = o;
    }
}

constexpr int XA_KRS = 272, XA_VOFF = 256 * XA_KRS, XA_VIMG = 256 * 64;
static_assert(XA_VOFF + 4 * XA_VIMG <= LDS_BYTES, "xattn LDS");
__device__ __forceinline__ void xattn_unit(LAS unsigned char* lds, int unit, bf16* XQ, const bf16* KV) {
    const int tid = threadIdx.x, lane = tid & 63, wid = __builtin_amdgcn_readfirstlane(tid >> 6), r32 = lane & 31, hi = lane >> 5;
    const int rt = unit & 15, h = (unit >> 4) & 3, b = unit >> 6;
#pragma unroll
    for (int i = 0; i < 8; ++i) {
        const int c = tid + NTHREADS * i, key = c >> 4, ch = c & 15; const size_t go = (size_t)(b * MEMT + key) * 1024 + h * 128 + ch * 8;
        const u32x4 kv = *(const u32x4*)(KV + go), vv = *(const u32x4*)(KV + go + 512);
        *(LAS u32x4*)(lds + key * XA_KRS + ch * 16) = kv;
        *(LAS u32x4*)(lds + XA_VOFF + (ch >> 2) * XA_VIMG + key * 64 + (ch & 3) * 16) = vv;
    }
    __syncthreads();
    bf16* qp = XQ + (size_t)(b * SEQ + rt * 256 + wid * 32 + r32) * XW + h * 128;
    const int q4 = (lane & 15) >> 2, p4 = lane & 3, dh = (lane >> 4) & 1;
    f32x16 s[8];
#pragma unroll
    for (int jb = 0; jb < 8; ++jb) s[jb] = (f32x16){};
#pragma unroll
    for (int ds = 0; ds < 8; ++ds) {
        const bf16x8 qf = *(const bf16x8*)(qp + 16 * ds + 8 * hi);
#pragma unroll
        for (int jb = 0; jb < 8; ++jb) s[jb] = MFMA32(*(const LAS bf16x8*)(lds + (32 * jb + r32) * XA_KRS + hi * 16 + ds * 32), qf, s[jb]);
    }
    float mx = -__builtin_inff();
#pragma unroll
    for (int jb = 0; jb < 8; ++jb)
#pragma unroll
        for (int r = 0; r < 16; ++r) mx = fmaxf(mx, s[jb][r]);
    mx = fmaxf(mx, __shfl_xor(mx, 32));
    float l = 0.f;
    bf16x8 pf[8][2];
#pragma unroll
    for (int jb = 0; jb < 8; ++jb) {
#pragma unroll
        for (int r = 0; r < 16; ++r) { const float p = __builtin_amdgcn_exp2f(s[jb][r] - mx); s[jb][r] = p; l += p; }
#pragma unroll
        for (int s2 = 0; s2 < 2; ++s2) { u32x4 w; w.x = pg8::cvt_pk_bf16(s[jb][8 * s2 + 0], s[jb][8 * s2 + 1]); w.y = pg8::cvt_pk_bf16(s[jb][8 * s2 + 2], s[jb][8 * s2 + 3]);
            w.z = pg8::cvt_pk_bf16(s[jb][8 * s2 + 4], s[jb][8 * s2 + 5]); w.w = pg8::cvt_pk_bf16(s[jb][8 * s2 + 6], s[jb][8 * s2 + 7]); pf[jb][s2] = __builtin_bit_cast(bf16x8, w); }
    }
    l += __shfl_xor(l, 32);
    const float inv = 1.0f / l;
#pragma unroll
    for (int db = 0; db < 4; ++db) {
        const LAS unsigned char* vp = lds + XA_VOFF + db * XA_VIMG + (4 * hi + q4) * 64 + dh * 32 + p4 * 8;
        f32x16 o = {};
#pragma unroll
        for (int jb = 0; jb < 8; ++jb)
#pragma unroll
            for (int s2 = 0; s2 < 2; ++s2) { const s16x4 lo = vtr(vp + (32 * jb + 16 * s2) * 64), h8 = vtr(vp + (32 * jb + 16 * s2 + 8) * 64);
                const bf16x8 vf = (bf16x8){lo[0], lo[1], lo[2], lo[3], h8[0], h8[1], h8[2], h8[3]};
                o = MFMA32(vf, pf[jb][s2], o); }
#pragma unroll
        for (int gi = 0; gi < 4; ++gi) { u32x2 w; w.x = pg8::cvt_pk_bf16(o[4 * gi] * inv, o[4 * gi + 1] * inv); w.y = pg8::cvt_pk_bf16(o[4 * gi + 2] * inv, o[4 * gi + 3] * inv);
            *(u32x2*)(qp + 32 * db + 8 * gi + 4 * hi) = w; }
    }
    __syncthreads();
}

__global__ void __launch_bounds__(NTHREADS, 2) fwd_mega(Args a) {
    extern __shared__ __attribute__((aligned(16))) unsigned char lds_raw[];
    LAS unsigned char* lds = (LAS unsigned char*)lds_raw;
    cg::grid_group grid = cg::this_grid();
    const int tid = threadIdx.x, lane = tid & 63, wave = __builtin_amdgcn_readfirstlane(tid >> 6);
    const int G = gridDim.x, bx = blockIdx.x;
    const int vcu = (G % 8 == 0) ? (bx % 8) * (G / 8) + bx / 8 : bx;
    const int gw = vcu * NWAVES + wave, NGW = G * NWAVES;
    unsigned char* ws = a.ws;
    float* ss0 = (float*)(ws + WS_SS); float* ss1 = ss0 + M; float* ss2 = ss1 + M; const float* rope = (const float*)(ws + WS_ROPE);
    bf16* memn = (bf16*)(ws + WS_MEMN); bf16* kvx = (bf16*)(ws + WS_KV);
    bf16* xb = (bf16*)(ws + WS_XB); bf16* q = (bf16*)(ws + WS_Q); bf16* k = (bf16*)(ws + WS_K); bf16* v = (bf16*)(ws + WS_V);
    bf16* cz = (bf16*)(ws + WS_CZ); bf16* gb = (bf16*)(ws + WS_GB); bf16* sa = (bf16*)(ws + WS_SA); bf16* sc = (bf16*)(ws + WS_SC);
    bf16* hb = (bf16*)(ws + WS_HB); bf16* merged = xb; bf16* xq = q; bf16* act = (bf16*)(ws + WS_ACT);
    float* T1 = a.out; float* H = a.out;
    const int lo = a.ph_lo, hi = a.ph_hi;
#define IN(k) (lo <= (k) && (k) < hi)
#define SEAM(k) do { if (IN(k) && IN((k) + 1)) grid.sync(); } while (0)
    using namespace pg8;
    if (IN(0)) { p0_prologue(a, lds, gw, NGW, wave, lane); }
    SEAM(0);
    if (IN(1)) {
        { Gemm g{xb, (const bf16*)(ws + WS_WIN), M, INW, D}; StaticOrder S; S.init(M, INW, G, bx);
          EpiIn E{q, k, v, cz, gb, sa, sc, ss0, rope};
          gemm_phase<EpiIn, StaticOrder, true, true>(lds, g, S, E); }
        { Gemm g{memn, (const bf16*)(ws + WS_WKV), MM, 1024, D}; StaticOrder S; S.init(MM, 1024, G, bx);
          EpiScale E{kvx, nullptr, 1024, 1.0f};
          gemm_phase<EpiScale, StaticOrder, true, true>(lds, g, S, E); }
    }
    SEAM(1);
    if (IN(2)) {
        for (int u = bx; u < 512; u += G) swa_unit(lds, u, q, k, v, a.in[5]);
        conv_items(cz, gb, a.in[4], vcu * NTHREADS + tid, G * NTHREADS);
    }
    SEAM(2);
    if (IN(3)) {
        { Gemm g{q, (const bf16*)(ws + WS_WAP), M, D, 1024}; StaticOrder S; S.init(M, D, G, bx);
          EpiT1 E{T1, sa};
          gemm_phase<EpiT1, StaticOrder, true, true>(lds, g, S, E); }
        { Gemm g{gb, (const bf16*)(ws + WS_WCP), M, D, 1024}; StaticOrder S; S.init(M, D, G, bx);
          EpiMerged E{T1, sc, merged};
          gemm_phase<EpiMerged, StaticOrder, true, true>(lds, g, S, E); }
    }
    SEAM(3);
    if (IN(4)) {
        Gemm g{merged, (const bf16*)(ws + WS_WMO), M, D, D}; StaticOrder S; S.init(M, D, G, bx);
        EpiRes E{a.in[0], H, hb, ss1};
        gemm_phase<EpiRes, StaticOrder, true, true>(lds, g, S, E);
    }
    SEAM(4);
    if (IN(5)) {
        Gemm g{hb, (const bf16*)(ws + WS_WXQ), M, XW, D}; StaticOrder S; S.init(M, XW, G, bx);
        EpiScale E{xq, ss1, XW, XSCALE};
        gemm_phase<EpiScale, StaticOrder, true, true>(lds, g, S, E);
    }
    SEAM(5);
    if (IN(6)) { for (int u = bx; u < 256; u += G) xattn_unit(lds, u, xq, kvx); }
    SEAM(6);
    if (IN(7)) {
        Gemm g{xq, (const bf16*)(ws + WS_WXO), M, D, XW}; StaticOrder S; S.init(M, D, G, bx);
        EpiRes E{H, H, hb, ss2};
        gemm_phase<EpiRes, StaticOrder, true, true>(lds, g, S, E);
    }
    SEAM(7);
    if (IN(8)) {
        Gemm g{hb, (const bf16*)(ws + WS_WFI), M, 2 * FFN, D}; StaticOrder S; S.init(M, 2 * FFN, G, bx);
        EpiFfn E{act, ss2};
        gemm_phase<EpiFfn, StaticOrder, true, true>(lds, g, S, E);
    }
    SEAM(8);
    if (IN(9)) {
        Gemm g{act, (const bf16*)(ws + WS_WFO), M, D, FFN}; StaticOrder S; S.init(M, D, G, bx);
        EpiRes E{H, H, nullptr, nullptr};
        gemm_phase<EpiRes, StaticOrder, true, true>(lds, g, S, E);
    }
    SEAM(9);
    if (IN(10)) {
        const float* gf = a.in[17];
        for (int m = gw; m < M; m += NGW) {
            f32x4* r = (f32x4*)(a.out + (size_t)m * D) + lane; const f32x4* gr = (const f32x4*)gf + lane; f32x4 vv[8]; float s = 0.f;
#pragma unroll
            for (int j = 0; j < 8; ++j) { vv[j] = r[64 * j]; s += (vv[j].x * vv[j].x + vv[j].y * vv[j].y) + (vv[j].z * vv[j].z + vv[j].w * vv[j].w); }
            const float rs = __builtin_amdgcn_rsqf(wave_sum(s) * (1.0f / D) + EPS);
#pragma unroll
            for (int j = 0; j < 8; ++j) r[64 * j] = vv[j] * rs * gr[64 * j];
        }
    }
#undef IN
#undef SEAM
}

extern "C" void kernel_launch(void* const* d_in, const int* in_sizes, int n_in, void* d_out, int out_size, void* d_ws, size_t ws_size, hipStream_t stream) {
    static int grid = 0;
    if (grid == 0) {
        if (n_in != 18 || out_size != M * D || ws_size < WS_END) { fprintf(stderr, "kernel_launch: unexpected shapes (n_in %d out %d ws %zu)\n", n_in, out_size, ws_size); grid = -1; return; }
        int dev = 0, cus = 0, per_cu = 0;
        if (hipGetDevice(&dev) != hipSuccess || hipDeviceGetAttribute(&cus, hipDeviceAttributeMultiprocessorCount, dev) != hipSuccess) { grid = -1; return; }
        if (hipFuncSetAttribute((const void*)fwd_mega, hipFuncAttributeMaxDynamicSharedMemorySize, LDS_BYTES) != hipSuccess) { fprintf(stderr, "kernel_launch: hipFuncSetAttribute failed\n"); grid = -1; return; }
        if (hipOccupancyMaxActiveBlocksPerMultiprocessor(&per_cu, (const void*)fwd_mega, NTHREADS, LDS_BYTES) != hipSuccess || per_cu < 1) { fprintf(stderr, "kernel_launch: occupancy query says %d blocks per CU\n", per_cu); (void)hipGetLastError(); grid = -1; return; }
        grid = cus;
    }
    if (grid < 0) return;
    (void)hipMemsetAsync((char*)d_ws + WS_SS + (size_t)M * 4, 0, 2 * (size_t)M * 4, stream);
    Args a{};
    for (int i = 0; i < 18; ++i) a.in[i] = (const float*)d_in[i];
    a.out = (float*)d_out; a.ws = (unsigned char*)d_ws; a.ph_lo = 0; a.ph_hi = 11;
    void* args[] = {&a};
    hipError_t e = hipLaunchCooperativeKernel((const void*)fwd_mega, dim3(grid), dim3(NTHREADS), args, LDS_BYTES, stream);
    if (e != hipSuccess) fprintf(stderr, "kernel_launch: cooperative launch failed: %s (grid %d)\n", hipGetErrorString(e), grid);
}
```

```cpp
#include <hip/hip_runtime.h>
#include <hip/hip_cooperative_groups.h>
#include <cstdio>
#include <cstdint>
namespace cg = cooperative_groups;
#ifndef USE_CG_FIRST
#define USE_CG_FIRST 1
#endif
namespace pg8 {
#define PG8_LAS __attribute__((address_space(3)))
typedef unsigned short bf16_t;
typedef short bf16x8 __attribute__((ext_vector_type(8)));
typedef float f32x4 __attribute__((ext_vector_type(4)));
typedef unsigned u32x4 __attribute__((ext_vector_type(4)));
constexpr int BM = 256, BK = 64, HALF = 128, HTB = HALF * BK * 2  , STAGE_BYTES = 8 * HTB, NXCD = 8, WGM = 8;

__host__ __device__ __forceinline__ int lds_byte(int r, int c) { const int st = (r >> 4) * 2 + (c >> 5), rr = r & 15, cc = c & 31, ob = rr * 64 + cc * 2; return st * 1024 + (ob ^ (((ob >> 9) & 1) << 5)); }
__host__ __device__ __forceinline__ void stage_rc(int b, int& R, int& C) { const int st = b / 1024, sb = b % 1024, swz = sb ^ (((sb >> 9) & 1) << 5); R = (st >> 1) * 16 + swz / 64; C = (st & 1) * 32 + (swz % 64) / 2; }
__host__ __device__ __forceinline__ int perm32(int rho) { const int n = rho >> 4, i = rho & 15; return 8 * (i >> 2) + 4 * n + (i & 3); }

struct Unit { int pm, pn; };
struct Gemm { const bf16_t* A; const bf16_t* Bt; int M, N, K; };

struct StaticOrder {
    int nM, nN, nwg, G, c;
    __host__ __device__ void init(int M, int N, int G_, int c_) { nM = M / BM; nN = N / BM; nwg = nM * nN; G = G_; c = c_; }
    __host__ __device__ bool next(int i, Unit& u) const {
        const long L = (long)i * G + c; if (L >= nwg) return false;
        int wgid = (int)L; { const int q = nwg / NXCD, r = nwg % NXCD, xcd = wgid % NXCD, off = wgid / NXCD; wgid = (xcd < r ? xcd * (q + 1) : r * (q + 1) + (xcd - r) * q) + off; }
        const int nig = WGM * nN, gid = wgid / nig, fm = gid * WGM, gsz = (nM - fm) < WGM ? (nM - fm) : WGM;
        u.pm = fm + ((wgid % nig) % gsz); u.pn = (wgid % nig) / gsz; return true;
    }
    __device__ __forceinline__ void a_ready(const Unit&) const {}
    __device__ __forceinline__ void done(const Unit&) const {}
};

__device__ __forceinline__ unsigned cvt_pk_bf16(float lo, float hi) { unsigned r; asm volatile("v_cvt_pk_bf16_f32 %0, %1, %2" : "=v"(r) : "v"(lo), "v"(hi)); return r; }
typedef float f32x2 __attribute__((ext_vector_type(2)));
template <class Epi, class Sched, bool ALIGN_EPI = false, bool SP2 = false>
__device__ __forceinline__ void gemm_phase(PG8_LAS unsigned char* lds, const Gemm g, const Sched& S, const Epi& E) {
    const int tid = threadIdx.x, wid = __builtin_amdgcn_readfirstlane(tid >> 6), lane = tid & 63, wr = wid >> 2, wc = wid & 3, fr = lane & 15, fq = lane >> 4;
    const int K = g.K, nt = K / BK;
    unsigned voffA[2], voffB[2];
#pragma unroll
    for (int i = 0; i < 2; ++i) { int R, C; stage_rc(tid * 16 + i * 8192, R, C); const int Rb = Epi::PERM ? ((R & ~31) + perm32(R & 31)) : R;
        voffA[i] = (unsigned)(R * K + C) * 2u; voffB[i] = (unsigned)(Rb * K + C) * 2u; }
    const size_t kstep = (size_t)(BK * 2);
    const size_t hstep = (size_t)HALF * K * 2;
    const size_t tstep = 2 * hstep;
    const unsigned ldsw = (unsigned)wid * 1024u;
    const int aoff = lds_byte(wr * 64 + fr, fq * 8), boff = lds_byte(wc * 32 + fr, fq * 8);
#define PG8_SA(b, h) (((b) * 2 + (h)) * HTB)
#define PG8_SB(b, h) ((4 + (b) * 2 + (h)) * HTB)
#define PG8_STAGE(bufoff, gbase, voff) do { _Pragma("unroll") for (int _i = 0; _i < 2; ++_i) \
        __builtin_amdgcn_global_load_lds((const unsigned*)((const char*)(gbase) + (voff)[_i]), (PG8_LAS unsigned*)(lds + (bufoff) + ldsw + _i * 8192), 16, 0, 0); } while (0)
#define PG8_LDA(dst, b, h) do { _Pragma("unroll") for (int m = 0; m < 4; ++m) _Pragma("unroll") for (int k = 0; k < 2; ++k) dst[m][k] = *(const PG8_LAS bf16x8*)(lds + PG8_SA(b, h) + aoff + m * 2048 + k * 1024); } while (0)
#define PG8_LDB(dst, b, h) do { _Pragma("unroll") for (int n = 0; n < 2; ++n) _Pragma("unroll") for (int k = 0; k < 2; ++k) dst[n][k] = *(const PG8_LAS bf16x8*)(lds + PG8_SB(b, h) + boff + n * 2048 + k * 1024); } while (0)
#define PG8_MMA(ai, bj, At, Bt) do { __builtin_amdgcn_s_setprio(1); _Pragma("unroll") for (int m = 0; m < 4; ++m) _Pragma("unroll") for (int n = 0; n < 2; ++n) _Pragma("unroll") for (int k = 0; k < 2; ++k) \
        acc[ai][bj][m][n] = __builtin_amdgcn_mfma_f32_16x16x32_bf16(Bt[n][k], At[m][k], acc[ai][bj][m][n], 0, 0, 0); __builtin_amdgcn_s_setprio(0); } while (0)
#define PG8_WAIT_V(n) asm volatile("s_waitcnt vmcnt(" #n ")" ::: "memory")
#define PG8_WAIT_L(n) asm volatile("s_waitcnt lgkmcnt(" #n ")" ::: "memory")
#define PG8_BAR __builtin_amdgcn_s_barrier()
#define PG8_SCHED __builtin_amdgcn_sched_barrier(0)
    Unit cur, nxt; int ui = 0;
    if (!S.next(0, cur)) return;
    f32x4 acc[2][2][4][2];
#pragma unroll
    for (int a = 0; a < 2; ++a)
#pragma unroll
        for (int b = 0; b < 2; ++b)
#pragma unroll
            for (int m = 0; m < 4; ++m)
#pragma unroll
                for (int n = 0; n < 2; ++n) acc[a][b][m][n] = (f32x4){0.f, 0.f, 0.f, 0.f};
    bf16x8 At[4][2], B0[2][2], B1[2][2];
    const char* cA = (const char*)g.A + (size_t)cur.pm * tstep; const char* cB = (const char*)g.Bt + (size_t)cur.pn * tstep;
    S.a_ready(cur);
    if constexpr (SP2) {
        PG8_STAGE(PG8_SB(0, 0), cB, voffB); PG8_STAGE(PG8_SB(0, 1), cB + hstep, voffB); PG8_STAGE(PG8_SA(0, 0), cA, voffA); PG8_STAGE(PG8_SA(0, 1), cA + hstep, voffA);
        if (wr == 1) PG8_BAR;
        PG8_WAIT_V(2); PG8_BAR;
        PG8_STAGE(PG8_SB(1, 0), cB + kstep, voffB); PG8_STAGE(PG8_SA(1, 0), cA + kstep, voffA); PG8_STAGE(PG8_SB(1, 1), cB + hstep + kstep, voffB);
        PG8_WAIT_V(6); PG8_BAR;
    } else {
        PG8_STAGE(PG8_SB(0, 0), cB, voffB); PG8_STAGE(PG8_SA(0, 0), cA, voffA); PG8_STAGE(PG8_SB(0, 1), cB + hstep, voffB); PG8_STAGE(PG8_SA(0, 1), cA + hstep, voffA);
        if (wr == 1) PG8_BAR;
        PG8_WAIT_V(4); PG8_BAR;
        PG8_STAGE(PG8_SB(1, 0), cB + kstep, voffB); PG8_STAGE(PG8_SA(1, 0), cA + kstep, voffA); PG8_STAGE(PG8_SB(1, 1), cB + hstep + kstep, voffB);
        PG8_WAIT_V(6); PG8_BAR;
    }
    for (;;) {
        const bool has_next = S.next(ui + 1, nxt);
        const char* nA = has_next ? (const char*)g.A + (size_t)nxt.pm * tstep : cA; const char* nB = has_next ? (const char*)g.Bt + (size_t)nxt.pn * tstep : cB;
        for (int t = 0; t < nt; t += 2) {
            const bool last = (t == nt - 2);
            const char* a1 = cA + (size_t)(t + 1) * kstep;
            const char* a2 = last ? nA : cA + (size_t)(t + 2) * kstep; const char* b2 = last ? nB : cB + (size_t)(t + 2) * kstep;
            const char* a3 = a2 + kstep; const char* b3 = b2 + kstep;
            if (last && has_next) S.a_ready(nxt);
            if constexpr (SP2) {
            PG8_LDB(B0, 0, 0); PG8_LDB(B1, 0, 1); PG8_SCHED; PG8_LDA(At, 0, 0); PG8_STAGE(PG8_SA(1, 1), a1 + hstep, voffA);
            PG8_WAIT_V(8); PG8_WAIT_L(0); PG8_BAR; PG8_MMA(0, 0, At, B0); PG8_MMA(0, 1, At, B1); PG8_BAR; PG8_SCHED;
            PG8_LDA(At, 0, 1); PG8_STAGE(PG8_SB(0, 0), b2, voffB); PG8_STAGE(PG8_SB(0, 1), b2 + hstep, voffB); PG8_STAGE(PG8_SA(0, 0), a2, voffA);
            PG8_WAIT_V(8); PG8_WAIT_L(0); PG8_BAR; PG8_MMA(1, 0, At, B0); PG8_MMA(1, 1, At, B1); PG8_BAR; PG8_SCHED;
            PG8_LDB(B0, 1, 0); PG8_LDB(B1, 1, 1); PG8_SCHED; PG8_LDA(At, 1, 0); PG8_STAGE(PG8_SA(0, 1), a2 + hstep, voffA);
            PG8_WAIT_V(8); PG8_WAIT_L(0); PG8_BAR; PG8_MMA(0, 0, At, B0); PG8_MMA(0, 1, At, B1); PG8_BAR; PG8_SCHED;
            PG8_LDA(At, 1, 1); PG8_STAGE(PG8_SB(1, 0), b3, voffB); PG8_STAGE(PG8_SB(1, 1), b3 + hstep, voffB); PG8_STAGE(PG8_SA(1, 0), a3, voffA);
            PG8_WAIT_V(8); PG8_WAIT_L(0); PG8_BAR; PG8_MMA(1, 0, At, B0); PG8_MMA(1, 1, At, B1); PG8_BAR; PG8_SCHED;
            } else {
            PG8_LDB(B0, 0, 0); PG8_SCHED; PG8_LDA(At, 0, 0); PG8_STAGE(PG8_SA(1, 1), a1 + hstep, voffA);
            PG8_WAIT_L(8); PG8_BAR; PG8_WAIT_L(0); PG8_MMA(0, 0, At, B0); PG8_BAR; PG8_SCHED;
            PG8_LDB(B1, 0, 1); PG8_STAGE(PG8_SB(0, 0), b2, voffB);
            PG8_BAR; PG8_WAIT_L(0); PG8_MMA(0, 1, At, B1); PG8_BAR;
            PG8_LDA(At, 0, 1); PG8_STAGE(PG8_SA(0, 0), a2, voffA);
            PG8_BAR; PG8_WAIT_L(0); PG8_MMA(1, 0, At, B0); PG8_BAR; PG8_SCHED;
            PG8_STAGE(PG8_SB(0, 1), b2 + hstep, voffB);
            PG8_WAIT_V(6); PG8_BAR; PG8_MMA(1, 1, At, B1); PG8_BAR;
            PG8_LDB(B0, 1, 0); PG8_SCHED; PG8_LDA(At, 1, 0); PG8_STAGE(PG8_SA(0, 1), a2 + hstep, voffA);
            PG8_WAIT_L(8); PG8_BAR; PG8_WAIT_L(0); PG8_MMA(0, 0, At, B0); PG8_BAR; PG8_SCHED;
            PG8_LDB(B1, 1, 1); PG8_STAGE(PG8_SB(1, 0), b3, voffB);
            PG8_BAR; PG8_WAIT_L(0); PG8_MMA(0, 1, At, B1); PG8_BAR;
            PG8_LDA(At, 1, 1); PG8_STAGE(PG8_SA(1, 0), a3, voffA);
            PG8_BAR; PG8_WAIT_L(0); PG8_MMA(1, 0, At, B0); PG8_BAR; PG8_SCHED;
            PG8_STAGE(PG8_SB(1, 1), b3 + hstep, voffB);
            PG8_WAIT_V(6); PG8_BAR; PG8_MMA(1, 1, At, B1); PG8_BAR;
            }
        }
        if constexpr (ALIGN_EPI) { if (wr == 0) PG8_BAR; }
        if constexpr (!Epi::AFTER_DRAIN) { E(acc, cur, wr, wc, fr, fq); S.done(cur); }
        if (!has_next) break;
#pragma unroll
        for (int a = 0; a < 2; ++a)
#pragma unroll
            for (int b = 0; b < 2; ++b)
#pragma unroll
                for (int m = 0; m < 4; ++m)
#pragma unroll
                    for (int n = 0; n < 2; ++n) acc[a][b][m][n] = (f32x4){0.f, 0.f, 0.f, 0.f};
        cur = nxt; cA = nA; cB = nB; ++ui;
        if constexpr (ALIGN_EPI) { if (wr == 1) PG8_BAR; }
    }
    PG8_WAIT_V(0);
    if constexpr (!ALIGN_EPI) { if (wr == 0) PG8_BAR; }
    PG8_BAR;
    if constexpr (Epi::AFTER_DRAIN) { E.fused(acc, cur, wr, wc, fr, fq, lds, wid, lane); S.done(cur); }
#undef PG8_SA
#undef PG8_SB
#undef PG8_STAGE
#undef PG8_LDA
#undef PG8_LDB
#undef PG8_MMA
#undef PG8_WAIT_V
#undef PG8_WAIT_L
#undef PG8_BAR
#undef PG8_SCHED
}
constexpr float LOG2E = 1.4426950408889634f;
constexpr float QSCALE = 0.125f * LOG2E;
constexpr float XSCALE = 0.08838834764831845f * LOG2E;
typedef unsigned u32x2 __attribute__((ext_vector_type(2)));
__device__ __forceinline__ float rstd_v(float ssv) { return __builtin_amdgcn_rsqf(ssv * (1.0f / 2048.0f) + 1e-6f); }
__device__ __forceinline__ float rstd_of(const float* ss, int row) { return __builtin_amdgcn_rsqf(ss[row] * (1.0f / 2048.0f) + 1e-6f); }
__device__ __forceinline__ f32x4 sigmoid4(f32x4 v) { f32x4 o;
#pragma unroll
    for (int i = 0; i < 4; ++i) o[i] = __builtin_amdgcn_rcpf(1.0f + __builtin_amdgcn_exp2f(-LOG2E * v[i]));
    return o; }
__device__ __forceinline__ u32x4 pack8(f32x4 a, f32x4 b) { u32x4 w; w.x = cvt_pk_bf16(a[0], a[1]); w.y = cvt_pk_bf16(a[2], a[3]); w.z = cvt_pk_bf16(b[0], b[1]); w.w = cvt_pk_bf16(b[2], b[3]); return w; }
__device__ __forceinline__ void unpack8(u32x4 w, f32x4& a, f32x4& b) {
    a[0] = __uint_as_float(w.x << 16); a[1] = __uint_as_float(w.x & 0xffff0000u); a[2] = __uint_as_float(w.y << 16); a[3] = __uint_as_float(w.y & 0xffff0000u);
    b[0] = __uint_as_float(w.z << 16); b[1] = __uint_as_float(w.z & 0xffff0000u); b[2] = __uint_as_float(w.w << 16); b[3] = __uint_as_float(w.w & 0xffff0000u); }

struct EpiIn {
    static constexpr bool PERM = true, AFTER_DRAIN = false;
    bf16_t *q, *k, *v, *cz, *gb, *sa, *sc; const float* ss; const float* rope;
    __device__ __forceinline__ void operator()(const f32x4 (&acc)[2][2][4][2], const Unit& u, int wr, int wc, int fr, int fq) const {
        const int row0 = u.pm * BM + wr * 64 + fr, pn = u.pn, cl = wc * 32 + 8 * fq;
        if (pn < 5) {
            bf16_t* base = pn < 4 ? q : k; const int ld = pn < 4 ? 1024 : 256, hbase = pn < 4 ? pn * 4 : 0; const float scale = pn < 4 ? QSCALE : 1.0f;
            const int jj = 4 * (wc & 1) + fq;
#pragma unroll
            for (int ai = 0; ai < 2; ++ai) {
                float rr[4]; f32x4 cs[4], sn[4];
#pragma unroll
                for (int m = 0; m < 4; ++m) { const int row = row0 + ai * HALF + m * 16, t = row & 4095; rr[m] = ss[row];
                    cs[m] = *(const f32x4*)(rope + t * 32 + 4 * jj); sn[m] = *(const f32x4*)(rope + 131072 + t * 32 + 4 * jj); }
#pragma unroll
                for (int m = 0; m < 4; ++m) { const int row = row0 + ai * HALF + m * 16; const float r = rstd_v(rr[m]);
#pragma unroll
                    for (int bj = 0; bj < 2; ++bj) { const f32x4 x1 = acc[ai][bj][m][0] * r, x2 = acc[ai][bj][m][1] * r;
                        const f32x4 o1 = (x1 * cs[m] - x2 * sn[m]) * scale, o2 = (x2 * cs[m] + x1 * sn[m]) * scale;
                        bf16_t* p = base + (size_t)row * ld + (hbase + 2 * bj + (wc >> 1)) * 64 + 4 * jj;
                        u32x2 w1, w2; w1.x = cvt_pk_bf16(o1[0], o1[1]); w1.y = cvt_pk_bf16(o1[2], o1[3]); w2.x = cvt_pk_bf16(o2[0], o2[1]); w2.y = cvt_pk_bf16(o2[2], o2[3]);
                        *(u32x2*)p = w1; *(u32x2*)(p + 32) = w2; } }
            }
        } else if (pn >= 6 && pn < 14) {
            bf16_t* base = cz + (pn - 6) * 128 + cl;
#pragma unroll
            for (int ai = 0; ai < 2; ++ai)
#pragma unroll
                for (int m = 0; m < 4; ++m) { const int row = row0 + ai * HALF + m * 16; const float r = rstd_of(ss, row), r2 = r * r;
                    *(u32x4*)(base + (size_t)row * 1024) = pack8(acc[ai][0][m][0] * acc[ai][1][m][0] * r2, acc[ai][0][m][1] * acc[ai][1][m][1] * r2); }
        } else {
            bf16_t* base; int ld; bool sig;
            if (pn == 5) { base = v; ld = 256; sig = false; } else if (pn < 18) { base = gb + (pn - 14) * 256; ld = 1024; sig = false; }
            else if (pn < 26) { base = sa + (pn - 18) * 256; ld = 2048; sig = true; } else { base = sc + (pn - 26) * 256; ld = 2048; sig = true; }
#pragma unroll
            for (int ai = 0; ai < 2; ++ai)
#pragma unroll
                for (int m = 0; m < 4; ++m) { const int row = row0 + ai * HALF + m * 16; const float r = rstd_of(ss, row);
#pragma unroll
                    for (int bj = 0; bj < 2; ++bj) { f32x4 v0 = acc[ai][bj][m][0] * r, v1 = acc[ai][bj][m][1] * r; if (sig) { v0 = sigmoid4(v0); v1 = sigmoid4(v1); }
                        *(u32x4*)(base + (size_t)row * ld + bj * HALF + cl) = pack8(v0, v1); } }
        }
    }
};
struct EpiScale {
    static constexpr bool PERM = true, AFTER_DRAIN = false;
    bf16_t* O; const float* ss; int ldc; float scale;
    __device__ __forceinline__ void operator()(const f32x4 (&acc)[2][2][4][2], const Unit& u, int wr, int wc, int fr, int fq) const {
        const int row0 = u.pm * BM + wr * 64 + fr, col0 = u.pn * BM + wc * 32 + 8 * fq;
#pragma unroll
        for (int ai = 0; ai < 2; ++ai)
#pragma unroll
            for (int m = 0; m < 4; ++m) { const int row = row0 + ai * HALF + m * 16; const float r = (ss ? rstd_of(ss, row) : 1.0f) * scale;
#pragma unroll
                for (int bj = 0; bj < 2; ++bj) *(u32x4*)(O + (size_t)row * ldc + col0 + bj * HALF) = pack8(acc[ai][bj][m][0] * r, acc[ai][bj][m][1] * r); }
    }
};
struct EpiFfn {
    static constexpr bool PERM = true, AFTER_DRAIN = false;
    bf16_t* O; const float* ss;
    __device__ __forceinline__ void operator()(const f32x4 (&acc)[2][2][4][2], const Unit& u, int wr, int wc, int fr, int fq) const {
        const int row0 = u.pm * BM + wr * 64 + fr, col0 = u.pn * HALF + wc * 32 + 8 * fq;
#pragma unroll
        for (int ai = 0; ai < 2; ++ai)
#pragma unroll
            for (int m = 0; m < 4; ++m) { const int row = row0 + ai * HALF + m * 16; const float r = rstd_of(ss, row);
                const f32x4 g0 = acc[ai][0][m][0] * r, g1 = acc[ai][0][m][1] * r, u0 = acc[ai][1][m][0] * r, u1 = acc[ai][1][m][1] * r;
                *(u32x4*)(O + (size_t)row * 5632 + col0) = pack8(g0 * sigmoid4(g0) * u0, g1 * sigmoid4(g1) * u1); }
    }
};
struct EpiT1 {
    static constexpr bool PERM = true, AFTER_DRAIN = false;
    float* T1; const bf16_t* sa;
    __device__ __forceinline__ void operator()(const f32x4 (&acc)[2][2][4][2], const Unit& u, int wr, int wc, int fr, int fq) const {
        const int row0 = u.pm * BM + wr * 64 + fr, col0 = u.pn * BM + wc * 32 + 8 * fq;
#pragma unroll
        for (int ai = 0; ai < 2; ++ai) {
            u32x4 g[4][2];
#pragma unroll
            for (int m = 0; m < 4; ++m)
#pragma unroll
                for (int bj = 0; bj < 2; ++bj) g[m][bj] = *(const u32x4*)(sa + (size_t)(row0 + ai * HALF + m * 16) * 2048 + col0 + bj * HALF);
#pragma unroll
            for (int m = 0; m < 4; ++m) { const size_t off = (size_t)(row0 + ai * HALF + m * 16) * 2048 + col0;
#pragma unroll
                for (int bj = 0; bj < 2; ++bj) { f32x4 g0, g1; unpack8(g[m][bj], g0, g1);
                    *(f32x4*)(T1 + off + bj * HALF) = g0 * acc[ai][bj][m][0]; *(f32x4*)(T1 + off + bj * HALF + 4) = g1 * acc[ai][bj][m][1]; } }
        }
    }
};
struct EpiMerged {
    static constexpr bool PERM = true, AFTER_DRAIN = false;
    const float* T1; const bf16_t* sc; bf16_t* O;
    __device__ __forceinline__ void operator()(const f32x4 (&acc)[2][2][4][2], const Unit& u, int wr, int wc, int fr, int fq) const {
        const int row0 = u.pm * BM + wr * 64 + fr, col0 = u.pn * BM + wc * 32 + 8 * fq;
#pragma unroll
        for (int ai = 0; ai < 2; ++ai)
#pragma unroll
            for (int mh = 0; mh < 2; ++mh) {
                u32x4 g[2][2]; f32x4 t[2][2][2];
#pragma unroll
                for (int mm = 0; mm < 2; ++mm)
#pragma unroll
                    for (int bj = 0; bj < 2; ++bj) { const size_t off = (size_t)(row0 + ai * HALF + (2 * mh + mm) * 16) * 2048 + col0 + bj * HALF;
                        g[mm][bj] = *(const u32x4*)(sc + off); t[mm][bj][0] = *(const f32x4*)(T1 + off); t[mm][bj][1] = *(const f32x4*)(T1 + off + 4); }
#pragma unroll
                for (int mm = 0; mm < 2; ++mm)
#pragma unroll
                    for (int bj = 0; bj < 2; ++bj) { const int m = 2 * mh + mm; const size_t off = (size_t)(row0 + ai * HALF + m * 16) * 2048 + col0 + bj * HALF; f32x4 g0, g1; unpack8(g[mm][bj], g0, g1);
                        *(u32x4*)(O + off) = pack8(t[mm][bj][0] + g0 * acc[ai][bj][m][0], t[mm][bj][1] + g1 * acc[ai][bj][m][1]); }
            }
    }
};
struct EpiRes {
    static constexpr bool PERM = true, AFTER_DRAIN = false;
    const float* base; float* out; bf16_t* ob; float* ss; int rmask;
    __device__ __forceinline__ void operator()(const f32x4 (&acc)[2][2][4][2], const Unit& u, int wr, int wc, int fr, int fq) const {
        const int row0 = u.pm * BM + wr * 64 + fr, col0 = u.pn * BM + wc * 32 + 8 * fq;
#pragma unroll
        for (int ai = 0; ai < 2; ++ai)
#pragma unroll
        for (int mh = 0; mh < 2; ++mh) {
            f32x4 pre[2][2][2];
#pragma unroll
            for (int mm = 0; mm < 2; ++mm)
#pragma unroll
                for (int bj = 0; bj < 2; ++bj) { const float* bp = base + (size_t)(row0 + ai * HALF + (2 * mh + mm) * 16) * 2048 + col0 + bj * HALF; pre[mm][bj][0] = *(const f32x4*)bp; pre[mm][bj][1] = *(const f32x4*)(bp + 4); }
#pragma unroll
            for (int mm = 0; mm < 2; ++mm) { const int m = 2 * mh + mm; const int row = row0 + ai * HALF + m * 16; const size_t off = (size_t)row * 2048 + col0, offo = (size_t)(row & rmask) * 2048 + col0; float s = 0.f;
#pragma unroll
                for (int bj = 0; bj < 2; ++bj) { const f32x4 h0 = pre[mm][bj][0] + acc[ai][bj][m][0], h1 = pre[mm][bj][1] + acc[ai][bj][m][1];
                    *(f32x4*)(out + offo + bj * HALF) = h0; *(f32x4*)(out + offo + bj * HALF + 4) = h1;
                    if (ob) *(u32x4*)(ob + off + bj * HALF) = pack8(h0, h1);
                    s += (h0[0] * h0[0] + h0[1] * h0[1]) + (h0[2] * h0[2] + h0[3] * h0[3]) + (h1[0] * h1[0] + h1[1] * h1[1]) + (h1[2] * h1[2] + h1[3] * h1[3]); }
                if (ss) { s += __shfl_xor(s, 16); s += __shfl_xor(s, 32); if (fq == 0) atomicAdd(ss + row, s); } }
        }
    }
};
struct EpiNull {
    static constexpr bool PERM = true, AFTER_DRAIN = false;
    float* O;
    __device__ __forceinline__ void operator()(const f32x4 (&acc)[2][2][4][2], const Unit& u, int wr, int wc, int fr, int fq) const {
        f32x4 s = (f32x4){0.f, 0.f, 0.f, 0.f};
#pragma unroll
        for (int ai = 0; ai < 2; ++ai)
#pragma unroll
            for (int bj = 0; bj < 2; ++bj)
#pragma unroll
                for (int m = 0; m < 4; ++m) { s += acc[ai][bj][m][0]; s += acc[ai][bj][m][1]; }
        *(f32x4*)(O + ((size_t)(u.pm * 64 + u.pn) % 4096) * 2048 + threadIdx.x * 4) = s;
    }
};
}

#define LAS __attribute__((address_space(3)))
typedef unsigned short bf16;
typedef unsigned u32x4 __attribute__((ext_vector_type(4)));
typedef unsigned u32x2 __attribute__((ext_vector_type(2)));
typedef float f32x4 __attribute__((ext_vector_type(4)));
typedef float f32x16 __attribute__((ext_vector_type(16)));
typedef short bf16x8 __attribute__((ext_vector_type(8)));
typedef short s16x4 __attribute__((ext_vector_type(4)));
constexpr int NWAVES = 8, NTHREADS = 512;
constexpr int D = 2048, SEQ = 4096, M = 16384, MEMT = 256, MM = 1024, INW = 8704, FFN = 5632, XW = 512;
constexpr float EPS = 1e-6f;
constexpr float LOG2E = 1.4426950408889634f;
constexpr size_t MiB = 1u << 20;
constexpr size_t WS_SS = 0;
constexpr size_t WS_BAR = 256 * 1024;
constexpr size_t WS_ROPE = 1 * MiB;
constexpr size_t WS_MEMN = 2 * MiB;
constexpr size_t WS_KV = 6 * MiB;
constexpr size_t WS_W = 8 * MiB;
constexpr size_t WS_WIN = WS_W;
constexpr size_t WS_WFI = WS_WIN + 34 * MiB;
constexpr size_t WS_WFO = WS_WFI + 44 * MiB;
constexpr size_t WS_WMO = WS_WFO + 22 * MiB;
constexpr size_t WS_WAP = WS_WMO + 8 * MiB;
constexpr size_t WS_WCP = WS_WAP + 4 * MiB;
constexpr size_t WS_WXQ = WS_WCP + 4 * MiB;
constexpr size_t WS_WKV = WS_WXQ + 2 * MiB;
constexpr size_t WS_WXO = WS_WKV + 4 * MiB;
constexpr size_t WS_ACT0 = WS_WXO + 2 * MiB;
static_assert(WS_ACT0 == 132 * MiB, "ws map");
constexpr size_t WS_XB = WS_ACT0;
constexpr size_t WS_Q = WS_XB + 64 * MiB;
constexpr size_t WS_K = WS_Q + 32 * MiB;
constexpr size_t WS_V = WS_K + 8 * MiB;
constexpr size_t WS_CZ = WS_V + 8 * MiB;
constexpr size_t WS_GB = WS_CZ + 32 * MiB;
constexpr size_t WS_SA = WS_GB + 32 * MiB;
constexpr size_t WS_SC = WS_SA + 64 * MiB;
constexpr size_t WS_HB = WS_SC + 64 * MiB;
constexpr size_t WS_ACT = WS_CZ;
constexpr size_t WS_END = WS_HB + 64 * MiB;
constexpr int LDS_BYTES = 147456;

__device__ __forceinline__ float wave_sum(float v) {
#pragma unroll
    for (int o = 1; o < 64; o <<= 1) v += __shfl_xor(v, o);
    return v;
}
__device__ __forceinline__ unsigned f2bf(float f) { unsigned u = __builtin_bit_cast(unsigned, f); return (u + 0x7fffu + ((u >> 16) & 1u)) >> 16; }
__device__ __forceinline__ unsigned pk2(float lo, float hi) { return f2bf(lo) | (f2bf(hi) << 16); }
__device__ __forceinline__ float bflo(unsigned w) { return __uint_as_float(w << 16); }
__device__ __forceinline__ float bfhi(unsigned w) { return __uint_as_float(w & 0xffff0000u); }
__device__ __forceinline__ int crow(int r, int hi) { return (r & 3) + 8 * (r >> 2) + 4 * hi; }
typedef short v4i16_t __attribute__((ext_vector_type(4)));
__device__ __forceinline__ s16x4 vtr(const LAS unsigned char* p) { return __builtin_bit_cast(s16x4, __builtin_amdgcn_ds_read_tr16_b64_v4i16((LAS v4i16_t*)p)); }
#define MFMA32(a, b, c) __builtin_amdgcn_mfma_f32_32x32x16_bf16((a), (b), (c), 0, 0, 0)

__device__ __forceinline__ int src_in(int n) {
    if (n < 1280) { const int p = n & 63; return (n & ~63) + (p & 3) + 4 * (p >> 3) + 32 * ((p >> 2) & 1); }
    if (n < 1536) return n;
    if (n < 3584) { const int it = (n - 1536) >> 8, c = (n - 1536) & 255; return c < 128 ? 1536 + 128 * it + c : 3584 + 128 * it + (c - 128); }
    if (n < 4608) return 2560 + (n - 3584);
    return n;
}
__device__ __forceinline__ int src_ffn(int n) { const int pn = n >> 8, c = n & 255; return c < 128 ? 128 * pn + c : FFN + 128 * pn + (c - 128); }
template <int MAP> __device__ __forceinline__ void p0_transpose_item(const float* W, int ldw, int K, int Np, const float* g, bf16* WT, LAS float* scr, int item, int lane) {
    const int nblk = Np / 64, kb = item / nblk, nb = item % nblk, k0 = 64 * kb, n0 = 64 * nb, c4 = lane & 15, kq = lane >> 4;
    int sc;
    if (MAP == 1) {
        if (n0 < 1280) sc = n0 + 4 * ((c4 >> 1) + 8 * (c4 & 1));
        else if (n0 < 1536) sc = n0 + 4 * c4;
        else if (n0 < 3584) { const int it = (n0 - 1536) >> 8, cc = (n0 - 1536) & 255; sc = (cc < 128 ? 1536 + 128 * it + cc : 3584 + 128 * it + (cc - 128)) + 4 * c4; }
        else if (n0 < 4608) sc = 2560 + (n0 - 3584) + 4 * c4;
        else sc = n0 + 4 * c4;
    } else if (MAP == 2) { const int pn = n0 >> 8, cc = n0 & 255; sc = (cc < 128 ? 128 * pn + cc : FFN + 128 * pn + (cc - 128)) + 4 * c4; }
    else sc = n0 + 4 * c4;
    f32x4 v[16];
#pragma unroll
    for (int i = 0; i < 16; ++i) v[i] = *(const f32x4*)(W + (size_t)(k0 + 4 * i + kq) * ldw + sc);
    if (g) {
#pragma unroll
        for (int i = 0; i < 16; ++i) v[i] = v[i] * g[k0 + 4 * i + kq];
    }
#pragma unroll
    for (int i = 0; i < 16; ++i) { LAS float* d = scr + (4 * i + kq) * 65 + 4 * c4; d[0] = v[i].x; d[1] = v[i].y; d[2] = v[i].z; d[3] = v[i].w; }
    asm volatile("s_waitcnt lgkmcnt(0)" ::: "memory");
    const int c = lane & 7;
#pragma unroll
    for (int j = 0; j < 8; ++j) { const int n = (lane >> 3) + 8 * j; const LAS float* s = scr + (8 * c) * 65 + n;
        u32x4 o; o.x = pk2(s[0 * 65], s[1 * 65]); o.y = pk2(s[2 * 65], s[3 * 65]); o.z = pk2(s[4 * 65], s[5 * 65]); o.w = pk2(s[6 * 65], s[7 * 65]);
        *(u32x4*)(WT + (size_t)(n0 + n) * K + k0 + 8 * c) = o; }
    asm volatile("s_waitcnt lgkmcnt(0)" ::: "memory");
}

struct Args { const float* in[18]; float* out; unsigned char* ws; int ph_lo, ph_hi; };

__device__ __forceinline__ void p0_prologue(const Args& a, LAS unsigned char* lds, int gw, int NGW, int wave, int lane) {
    unsigned char* ws = a.ws;
    LAS float* scr = (LAS float*)(lds + wave * 16640);
    constexpr int I_IN = (D / 64) * (INW / 64), I_FI = (D / 64) * (2 * FFN / 64), I_FO = (FFN / 64) * (D / 64), I_MO = (D / 64) * (D / 64), I_AP = (1024 / 64) * (D / 64), I_CP = I_AP,
                  I_XQ = (D / 64) * (XW / 64), I_KV = (D / 64) * (1024 / 64), I_XO = (XW / 64) * (D / 64);
    constexpr int NITEMS = I_IN + I_FI + I_FO + I_MO + I_AP + I_CP + I_XQ + I_KV + I_XO;
    for (int it = gw; it < NITEMS; it += NGW) {
        int r = it;
        if (r < I_IN) { p0_transpose_item<1>(a.in[3], INW, D, INW, a.in[2], (bf16*)(ws + WS_WIN), scr, r, lane); continue; } r -= I_IN;
        if (r < I_FI) { p0_transpose_item<2>(a.in[15], 2 * FFN, D, 2 * FFN, a.in[14], (bf16*)(ws + WS_WFI), scr, r, lane); continue; } r -= I_FI;
        if (r < I_FO) { p0_transpose_item<0>(a.in[16], D, FFN, D, nullptr, (bf16*)(ws + WS_WFO), scr, r, lane); continue; } r -= I_FO;
        if (r < I_MO) { p0_transpose_item<0>(a.in[8], D, D, D, nullptr, (bf16*)(ws + WS_WMO), scr, r, lane); continue; } r -= I_MO;
        if (r < I_AP) { p0_transpose_item<0>(a.in[6], D, 1024, D, nullptr, (bf16*)(ws + WS_WAP), scr, r, lane); continue; } r -= I_AP;
        if (r < I_CP) { p0_transpose_item<0>(a.in[7], D, 1024, D, nullptr, (bf16*)(ws + WS_WCP), scr, r, lane); continue; } r -= I_CP;
        if (r < I_XQ) { p0_transpose_item<0>(a.in[11], XW, D, XW, a.in[9], (bf16*)(ws + WS_WXQ), scr, r, lane); continue; } r -= I_XQ;
        if (r < I_KV) { p0_transpose_item<0>(a.in[12], 1024, D, 1024, nullptr, (bf16*)(ws + WS_WKV), scr, r, lane); continue; } r -= I_KV;
        p0_transpose_item<0>(a.in[13], D, XW, D, nullptr, (bf16*)(ws + WS_WXO), scr, r, lane);
    }
    const float* x = a.in[0]; bf16* xb = (bf16*)(ws + WS_XB); float* ss0 = (float*)(ws + WS_SS);
    for (int m = 2 * gw; m < M; m += 2 * NGW) {
        const f32x4* xr = (const f32x4*)(x + (size_t)m * D) + lane; u32x2* o = (u32x2*)(xb + (size_t)m * D) + lane; f32x4 v[16];
#pragma unroll
        for (int j = 0; j < 16; ++j) v[j] = xr[64 * j];
        float s0 = 0.f, s1 = 0.f;
#pragma unroll
        for (int j = 0; j < 16; ++j) { const float q = (v[j].x * v[j].x + v[j].y * v[j].y) + (v[j].z * v[j].z + v[j].w * v[j].w); if (j < 8) s0 += q; else s1 += q;
            u32x2 w; w.x = pk2(v[j].x, v[j].y); w.y = pk2(v[j].z, v[j].w); o[64 * j] = w; }
        s0 = wave_sum(s0); s1 = wave_sum(s1); if (lane == 0) { ss0[m] = s0; ss0[m + 1] = s1; }
    }
    const float* mem = a.in[1]; const float* gm = a.in[10]; bf16* memn = (bf16*)(ws + WS_MEMN);
    for (int m = gw; m < MM; m += NGW) {
        const f32x4* xr = (const f32x4*)(mem + (size_t)m * D) + lane; const f32x4* gr = (const f32x4*)gm + lane; u32x2* o = (u32x2*)(memn + (size_t)m * D) + lane; f32x4 v[8]; float s = 0.f;
#pragma unroll
        for (int j = 0; j < 8; ++j) { v[j] = xr[64 * j]; s += (v[j].x * v[j].x + v[j].y * v[j].y) + (v[j].z * v[j].z + v[j].w * v[j].w); }
        const float rs = __builtin_amdgcn_rsqf(wave_sum(s) * (1.0f / D) + EPS);
#pragma unroll
        for (int j = 0; j < 8; ++j) { const f32x4 g = gr[64 * j]; u32x2 w; w.x = pk2(v[j].x * rs * g.x, v[j].y * rs * g.y); w.y = pk2(v[j].z * rs * g.z, v[j].w * rs * g.w); o[64 * j] = w; }
    }
    float* rope = (float*)(ws + WS_ROPE);
    for (int e = gw * 64 + lane; e < 4096 * 32; e += NGW * 64) {
        const int t = e >> 5, i = e & 31;
        const float inv = (float)exp(-(double)i / 32.0 * 9.210340371976184);
        const float ang = (float)t * inv;
        double rev = (double)ang * 0.15915494309189535; rev -= floor(rev + 0.5);
        const double xr = rev * 6.283185307179586, x2 = xr * xr;
        double sn = 0.0, cs = 0.0, ts = xr, tc = 1.0;
#pragma unroll
        for (int n = 0; n < 14; ++n) { cs += tc; sn += ts; tc *= -x2 / (double)((2 * n + 1) * (2 * n + 2)); ts *= -x2 / (double)((2 * n + 2) * (2 * n + 3)); }
        rope[e] = (float)cs; rope[4096 * 32 + e] = (float)sn;
    }
}

constexpr int SWA_KRS = 144, SWA_VOFF = 256 * SWA_KRS, SWA_VIMG = 256 * 64;
__device__ __forceinline__ void swa_unit(LAS unsigned char* lds, int unit, const bf16* Q, bf16* O, const bf16* Kg, const bf16* Vg, const float* sinks) {
    const int tid = threadIdx.x, lane = tid & 63, wid = __builtin_amdgcn_readfirstlane(tid >> 6), r32 = lane & 31, hi = lane >> 5;
    const int hk = unit & 3, nb = (unit >> 2) & 31, b = unit >> 7;
    const int tok0 = b * SEQ + nb * 128;
#pragma unroll
    for (int i = 0; i < 4; ++i) {
        const int c = tid + NTHREADS * i, key = c >> 3, ch = c & 7;
        u32x4 kv = (u32x4){0u, 0u, 0u, 0u}, vv = (u32x4){0u, 0u, 0u, 0u};
        if (nb > 0 || key >= 128) { const size_t go = (size_t)(tok0 - 128 + key) * 256 + hk * 64 + ch * 8; kv = *(const u32x4*)(Kg + go); vv = *(const u32x4*)(Vg + go); }
        *(LAS u32x4*)(lds + key * SWA_KRS + ch * 16) = kv;
        *(LAS u32x4*)(lds + SWA_VOFF + (ch >> 2) * SWA_VIMG + key * 64 + (ch & 3) * 16) = vv;
    }
    __syncthreads();
    const int g = wid >> 1, rh = wid & 1, head = hk * 4 + g;
    const float sink = sinks[head] * LOG2E;
    const float NEG = -__builtin_inff();
    const int q4 = (lane & 15) >> 2, p4 = lane & 3, dh = (lane >> 4) & 1;
    for (int sb = 0; sb < 2; ++sb) {
        const int kb0 = 2 * rh + sb;
        const size_t qo = (size_t)(tok0 + 32 * kb0 + r32) * 1024 + head * 64; const bf16* qp = Q + qo; bf16* op = O + qo;
        bf16x8 qf[4];
#pragma unroll
        for (int ds = 0; ds < 4; ++ds) qf[ds] = *(const bf16x8*)(qp + 16 * ds + 8 * hi);
        f32x16 s[5];
#pragma unroll
        for (int jb = 0; jb < 5; ++jb) {
            const LAS unsigned char* kp = lds + (32 * (kb0 + jb) + r32) * SWA_KRS + hi * 16;
            f32x16 c = {};
#pragma unroll
            for (int ds = 0; ds < 4; ++ds) c = MFMA32(*(const LAS bf16x8*)(kp + ds * 32), qf[ds], c);
            s[jb] = c;
        }
#pragma unroll
        for (int r = 0; r < 16; ++r) { const int kk = crow(r, hi); if (kk <= r32) s[0][r] = NEG; if (kk > r32) s[4][r] = NEG; }
        if (nb == 0) {
#pragma unroll
            for (int jb = 0; jb < 4; ++jb) if (kb0 + jb < 4) {
#pragma unroll
                for (int r = 0; r < 16; ++r) s[jb][r] = NEG; }
        }
        float mx = sink;
#pragma unroll
        for (int jb = 0; jb < 5; ++jb)
#pragma unroll
            for (int r = 0; r < 16; ++r) mx = fmaxf(mx, s[jb][r]);
        mx = fmaxf(mx, __shfl_xor(mx, 32));
        float l = 0.f;
#pragma unroll
        for (int jb = 0; jb < 5; ++jb)
#pragma unroll
            for (int r = 0; r < 16; ++r) { const float p = __builtin_amdgcn_exp2f(s[jb][r] - mx); s[jb][r] = p; l += p; }
        l += __shfl_xor(l, 32); l += __builtin_amdgcn_exp2f(sink - mx);
        bf16x8 pf[5][2];
#pragma unroll
        for (int jb = 0; jb < 5; ++jb)
#pragma unroll
            for (int s2 = 0; s2 < 2; ++s2) { u32x4 w; w.x = pg8::cvt_pk_bf16(s[jb][8 * s2 + 0], s[jb][8 * s2 + 1]); w.y = pg8::cvt_pk_bf16(s[jb][8 * s2 + 2], s[jb][8 * s2 + 3]);
                w.z = pg8::cvt_pk_bf16(s[jb][8 * s2 + 4], s[jb][8 * s2 + 5]); w.w = pg8::cvt_pk_bf16(s[jb][8 * s2 + 6], s[jb][8 * s2 + 7]); pf[jb][s2] = __builtin_bit_cast(bf16x8, w); }
        const float inv = 1.0f / l;
#pragma unroll
        for (int db = 0; db < 2; ++db) {
            const LAS unsigned char* vp = lds + SWA_VOFF + db * SWA_VIMG + (32 * kb0 + 4 * hi + q4) * 64 + dh * 32 + p4 * 8;
            f32x16 o = {};
#pragma unroll
            for (int jb = 0; jb < 5; ++jb)
#pragma unroll
                for (int s2 = 0; s2 < 2; ++s2) { const s16x4 lo = vtr(vp + (32 * jb + 16 * s2) * 64), h8 = vtr(vp + (32 * jb + 16 * s2 + 8) * 64);
                    const bf16x8 vf = (bf16x8){lo[0], lo[1], lo[2], lo[3], h8[0], h8[1], h8[2], h8[3]};
                    o = MFMA32(vf, pf[jb][s2], o); }
#pragma unroll
            for (int gi = 0; gi < 4; ++gi) { u32x2 w; w.x = pg8::cvt_pk_bf16(o[4 * gi] * inv, o[4 * gi + 1] * inv); w.y = pg8::cvt_pk_bf16(o[4 * gi + 2] * inv, o[4 * gi + 3] * inv);
                *(u32x2*)(op + 32 * db + 8 * gi + 4 * hi) = w; }
        }
    }
    __syncthreads();
}
__device__ __forceinline__ void conv_items(const bf16* cz, const bf16* gb, bf16* cv, const float* w, int gtid, int ngt) {
    for (int e = gtid; e < M * 128; e += ngt) {
        const int m = e >> 7, c = (e & 127) * 8, t = m & (SEQ - 1); const size_t off = (size_t)m * 1024 + c;
        const u32x4 z0 = *(const u32x4*)(cz + off), gv = *(const u32x4*)(gb + off);
        u32x4 z1 = (u32x4){0u, 0u, 0u, 0u}, z2 = (u32x4){0u, 0u, 0u, 0u};
        if (t >= 1) z1 = *(const u32x4*)(cz + off - 1024);
        if (t >= 2) z2 = *(const u32x4*)(cz + off - 2048);
        const f32x4 w0a = *(const f32x4*)(w + c), w0b = *(const f32x4*)(w + c + 4), w1a = *(const f32x4*)(w + 1024 + c), w1b = *(const f32x4*)(w + 1024 + c + 4), w2a = *(const f32x4*)(w + 2048 + c), w2b = *(const f32x4*)(w + 2048 + c + 4);
        u32x4 o;
#pragma unroll
        for (int j = 0; j < 4; ++j) {
            const float wl0 = j < 2 ? w0a[2 * j] : w0b[2 * j - 4], wh0 = j < 2 ? w0a[2 * j + 1] : w0b[2 * j - 3];
            const float wl1 = j < 2 ? w1a[2 * j] : w1b[2 * j - 4], wh1 = j < 2 ? w1a[2 * j + 1] : w1b[2 * j - 3];
            const float wl2 = j < 2 ? w2a[2 * j] : w2b[2 * j - 4], wh2 = j < 2 ? w2a[2 * j + 1] : w2b[2 * j - 3];
            const float lo = bflo(gv[j]) * (wl0 * bflo(z2[j]) + wl1 * bflo(z1[j]) + wl2 * bflo(z0[j]));
            const float hh = bfhi(gv[j]) * (wh0 * bfhi(z2[j]) + wh1 * bfhi(z1[j]) + wh2 * bfhi(z0[j]));
            o[j] = pg8::cvt_pk_bf16(lo, hh);
        }
        *(u32x4*)(cv + off) = o;
    }
}

constexpr int XA_KRS = 272, XA_VOFF = 256 * XA_KRS, XA_VIMG = 256 * 64;
static_assert(XA_VOFF + 4 * XA_VIMG <= LDS_BYTES, "xattn LDS");
__device__ __forceinline__ void xattn_unit(LAS unsigned char* lds, int unit, const bf16* XQ, bf16* XO, const bf16* KV) {
    const int tid = threadIdx.x, lane = tid & 63, wid = __builtin_amdgcn_readfirstlane(tid >> 6), r32 = lane & 31, hi = lane >> 5;
    const int rt = unit & 15, h = (unit >> 4) & 3, b = unit >> 6;
#pragma unroll
    for (int i = 0; i < 8; ++i) {
        const int c = tid + NTHREADS * i, key = c >> 4, ch = c & 15; const size_t go = (size_t)(b * MEMT + key) * 1024 + h * 128 + ch * 8;
        const u32x4 kv = *(const u32x4*)(KV + go), vv = *(const u32x4*)(KV + go + 512);
        *(LAS u32x4*)(lds + key * XA_KRS + ch * 16) = kv;
        *(LAS u32x4*)(lds + XA_VOFF + (ch >> 2) * XA_VIMG + key * 64 + (ch & 3) * 16) = vv;
    }
    __syncthreads();
    const size_t qo = (size_t)(b * SEQ + rt * 256 + wid * 32 + r32) * XW + h * 128; const bf16* qp = XQ + qo; bf16* op = XO + qo;
    const int q4 = (lane & 15) >> 2, p4 = lane & 3, dh = (lane >> 4) & 1;
    f32x16 s[8];
#pragma unroll
    for (int jb = 0; jb < 8; ++jb) s[jb] = (f32x16){};
#pragma unroll
    for (int ds = 0; ds < 8; ++ds) {
        const bf16x8 qf = *(const bf16x8*)(qp + 16 * ds + 8 * hi);
#pragma unroll
        for (int jb = 0; jb < 8; ++jb) s[jb] = MFMA32(*(const LAS bf16x8*)(lds + (32 * jb + r32) * XA_KRS + hi * 16 + ds * 32), qf, s[jb]);
    }
    float mx = -__builtin_inff();
#pragma unroll
    for (int jb = 0; jb < 8; ++jb)
#pragma unroll
        for (int r = 0; r < 16; ++r) mx = fmaxf(mx, s[jb][r]);
    mx = fmaxf(mx, __shfl_xor(mx, 32));
    float l = 0.f;
    bf16x8 pf[8][2];
#pragma unroll
    for (int jb = 0; jb < 8; ++jb) {
#pragma unroll
        for (int r = 0; r < 16; ++r) { const float p = __builtin_amdgcn_exp2f(s[jb][r] - mx); s[jb][r] = p; l += p; }
#pragma unroll
        for (int s2 = 0; s2 < 2; ++s2) { u32x4 w; w.x = pg8::cvt_pk_bf16(s[jb][8 * s2 + 0], s[jb][8 * s2 + 1]); w.y = pg8::cvt_pk_bf16(s[jb][8 * s2 + 2], s[jb][8 * s2 + 3]);
            w.z = pg8::cvt_pk_bf16(s[jb][8 * s2 + 4], s[jb][8 * s2 + 5]); w.w = pg8::cvt_pk_bf16(s[jb][8 * s2 + 6], s[jb][8 * s2 + 7]); pf[jb][s2] = __builtin_bit_cast(bf16x8, w); }
    }
    l += __shfl_xor(l, 32);
    const float inv = 1.0f / l;
#pragma unroll
    for (int db = 0; db < 4; ++db) {
        const LAS unsigned char* vp = lds + XA_VOFF + db * XA_VIMG + (4 * hi + q4) * 64 + dh * 32 + p4 * 8;
        f32x16 o = {};
#pragma unroll
        for (int jb = 0; jb < 8; ++jb)
#pragma unroll
            for (int s2 = 0; s2 < 2; ++s2) { const s16x4 lo = vtr(vp + (32 * jb + 16 * s2) * 64), h8 = vtr(vp + (32 * jb + 16 * s2 + 8) * 64);
                const bf16x8 vf = (bf16x8){lo[0], lo[1], lo[2], lo[3], h8[0], h8[1], h8[2], h8[3]};
                o = MFMA32(vf, pf[jb][s2], o); }
#pragma unroll
        for (int gi = 0; gi < 4; ++gi) { u32x2 w; w.x = pg8::cvt_pk_bf16(o[4 * gi] * inv, o[4 * gi + 1] * inv); w.y = pg8::cvt_pk_bf16(o[4 * gi + 2] * inv, o[4 * gi + 3] * inv);
            *(u32x2*)(op + 32 * db + 8 * gi + 4 * hi) = w; }
    }
    __syncthreads();
}


#define RLX_AGENT __ATOMIC_RELAXED, __HIP_MEMORY_SCOPE_AGENT
#define XB_TMO      128
#define XB_XCNT(j)  (256  + 64 * (j))
#define XB_XSUB(j)  (1280 + 64 * (j))
#define XB_XGEN(j)  (2304 + 64 * (j))
#define XB_TOP      3328
#define XB_TOPGEN   3392
#define XCD_BAR_WORDS 3456
#define XB_SPIN_CAP (1u << 18)

__device__ __forceinline__ unsigned xb_ld(unsigned* p)              { return __hip_atomic_load(p, __ATOMIC_RELAXED, __HIP_MEMORY_SCOPE_AGENT); }
__device__ __forceinline__ unsigned xb_add(unsigned* p, unsigned v) { return __hip_atomic_fetch_add(p, v, __ATOMIC_RELAXED, __HIP_MEMORY_SCOPE_AGENT); }
__device__ __forceinline__ unsigned xb_xcc_id() { return (unsigned)__builtin_amdgcn_s_getreg((3 << 11) | 20) & 0xFu; }
#define XB_SPIN(cond, bar) do { unsigned _sp = 0; while (cond) { __builtin_amdgcn_s_sleep(1); \
    if ((++_sp & 255u) == 0u) { if (xb_ld(&(bar)[XB_TMO])) break; if (_sp > XB_SPIN_CAP) { atomicAdd(&(bar)[XB_TMO], 1u); break; } } } } while (0)

struct XcdBarrier {
    unsigned* bar; unsigned x;
    volatile LAS unsigned* st;
};

__device__ __forceinline__ XcdBarrier xcd_barrier_post(unsigned* bar, volatile LAS unsigned* st) {
    XcdBarrier b; b.bar = bar; b.x = xb_xcc_id(); b.st = st;
    if (threadIdx.x == 0) (void)xb_add(&bar[XB_XCNT(b.x)], 1u);
    return b;
}
__device__ __forceinline__ void xcd_barrier_complete(unsigned* bar, unsigned x, unsigned& nloc, unsigned& nx) {
    const unsigned G = gridDim.x * gridDim.y * gridDim.z;
    unsigned sum, cnt, mine, sp = 0u;
    for (;;) {
        sum = 0u; cnt = 0u; mine = 0u;
#pragma unroll
        for (unsigned j = 0; j < 16; ++j) { const unsigned c = xb_ld(&bar[XB_XCNT(j)]); sum += c; cnt += (c > 0u) ? 1u : 0u; mine = (j == x) ? c : mine; }
        if (sum == G) break;
        __builtin_amdgcn_s_sleep(1);
        if ((++sp & 255u) == 0u) { if (xb_ld(&bar[XB_TMO])) break; if (sp > XB_SPIN_CAP) { atomicAdd(&bar[XB_TMO], 1u); break; } }
    }
    nloc = mine > 0u ? mine : 1u; nx = cnt > 0u ? cnt : 1u;
}

__device__ __forceinline__ void xcd_barrier(const XcdBarrier& b) {
    asm volatile("s_waitcnt vmcnt(0)" ::: "memory");
    __syncthreads();
    if (threadIdx.x == 0) {
        unsigned* bar = b.bar;
        __builtin_amdgcn_s_waitcnt(0);
        unsigned nloc = b.st[0], nx = b.st[1];
        if (nloc == 0u) { xcd_barrier_complete(bar, b.x, nloc, nx); b.st[0] = nloc; b.st[1] = nx; }
        const unsigned old = xb_add(&bar[XB_XSUB(b.x)], 1u);
        const unsigned gen = old / nloc;
        if (old + 1u == (gen + 1u) * nloc) {
            __builtin_amdgcn_fence(__ATOMIC_RELEASE, "agent");
            asm volatile("s_waitcnt vmcnt(0)" ::: "memory");
            const unsigned og = xb_add(&bar[XB_TOP], 1u);
            const unsigned tg = og / nx;
            if (og + 1u == (tg + 1u) * nx) xb_add(&bar[XB_TOPGEN], 1u);
            else XB_SPIN(xb_ld(&bar[XB_TOPGEN]) == tg, bar);
            __builtin_amdgcn_fence(__ATOMIC_ACQUIRE, "agent");
            xb_add(&bar[XB_XGEN(b.x)], 1u);
            asm volatile("s_waitcnt vmcnt(0)" ::: "memory");
        } else {
            XB_SPIN(xb_ld(&bar[XB_XGEN(b.x)]) == gen, bar);
            __builtin_amdgcn_fence(__ATOMIC_ACQUIRE, "agent");
            asm volatile("s_waitcnt vmcnt(0)" ::: "memory");
        }
    }
    __syncthreads();
}

#ifndef REP_SYNC
#define REP_SYNC 0
#endif
#ifndef REP_PH
#define REP_PH -1
#endif
struct Ctx {
    const Args* a; LAS unsigned char* lds; int G, bx, vcu, gw, NGW, tid, lane, wave;
};
#define WSP(T, off) ((T*)(c.a->ws + (off)))
__device__ __forceinline__ void ph1(const Ctx& c) {
    using namespace pg8;
    { Gemm g{WSP(bf16, WS_XB), WSP(const bf16, WS_WIN), M, INW, D}; StaticOrder S; S.init(M, INW, c.G, c.bx);
      EpiIn E{WSP(bf16, WS_Q), WSP(bf16, WS_K), WSP(bf16, WS_V), WSP(bf16, WS_CZ), WSP(bf16, WS_GB), WSP(bf16, WS_SA), WSP(bf16, WS_SC), WSP(const float, WS_SS), WSP(const float, WS_ROPE)};
      gemm_phase<EpiIn, StaticOrder, true, true>(c.lds, g, S, E); }
    { Gemm g{WSP(bf16, WS_MEMN), WSP(const bf16, WS_WKV), MM, 1024, D}; StaticOrder S; S.init(MM, 1024, c.G, c.bx);
      EpiScale E{WSP(bf16, WS_KV), nullptr, 1024, 1.0f};
      gemm_phase<EpiScale, StaticOrder, true, true>(c.lds, g, S, E); }
}
__device__ __forceinline__ void ph2(const Ctx& c, bool dry) {
    bf16* O = dry ? WSP(bf16, WS_HB) : WSP(bf16, WS_Q); bf16* cv = dry ? WSP(bf16, WS_HB + 32 * MiB) : WSP(bf16, WS_GB);
    for (int u = c.bx; u < 512; u += c.G) swa_unit(c.lds, u, WSP(const bf16, WS_Q), O, WSP(const bf16, WS_K), WSP(const bf16, WS_V), c.a->in[5]);
    conv_items(WSP(const bf16, WS_CZ), WSP(const bf16, WS_GB), cv, c.a->in[4], c.vcu * NTHREADS + c.tid, c.G * NTHREADS);
}
__device__ __forceinline__ void ph3(const Ctx& c) {
    using namespace pg8;
    { Gemm g{WSP(bf16, WS_Q), WSP(const bf16, WS_WAP), M, D, 1024}; StaticOrder S; S.init(M, D, c.G, c.bx);
      EpiT1 E{c.a->out, WSP(const bf16, WS_SA)};
      gemm_phase<EpiT1, StaticOrder, true, true>(c.lds, g, S, E); }
    { Gemm g{WSP(bf16, WS_GB), WSP(const bf16, WS_WCP), M, D, 1024}; StaticOrder S; S.init(M, D, c.G, c.bx);
      EpiMerged E{c.a->out, WSP(const bf16, WS_SC), WSP(bf16, WS_XB)};
      gemm_phase<EpiMerged, StaticOrder, true, true>(c.lds, g, S, E); }
}
__device__ __forceinline__ void ph4(const Ctx& c, bool with_ss) {
    using namespace pg8;
    Gemm g{WSP(bf16, WS_XB), WSP(const bf16, WS_WMO), M, D, D}; StaticOrder S; S.init(M, D, c.G, c.bx);
    EpiRes E{c.a->in[0], c.a->out, WSP(bf16, WS_HB), with_ss ? WSP(float, WS_SS) + M : nullptr, 0x7fffffff};
    gemm_phase<EpiRes, StaticOrder, true, true>(c.lds, g, S, E);
}
__device__ __forceinline__ void ph5(const Ctx& c) {
    using namespace pg8;
    Gemm g{WSP(bf16, WS_HB), WSP(const bf16, WS_WXQ), M, XW, D}; StaticOrder S; S.init(M, XW, c.G, c.bx);
    EpiScale E{WSP(bf16, WS_Q), WSP(const float, WS_SS) + M, XW, XSCALE};
    gemm_phase<EpiScale, StaticOrder, true, true>(c.lds, g, S, E);
}
__device__ __forceinline__ void ph6(const Ctx& c, bool dry) { bf16* O = dry ? WSP(bf16, WS_XB) : WSP(bf16, WS_Q); for (int u = c.bx; u < 256; u += c.G) xattn_unit(c.lds, u, WSP(const bf16, WS_Q), O, WSP(const bf16, WS_KV)); }
__device__ __forceinline__ void ph7(const Ctx& c, bool dry) {
    using namespace pg8;
    Gemm g{WSP(bf16, WS_Q), WSP(const bf16, WS_WXO), M, D, XW}; StaticOrder S; S.init(M, D, c.G, c.bx);
    EpiRes E{c.a->out, dry ? WSP(float, WS_XB) : c.a->out, dry ? nullptr : WSP(bf16, WS_HB), dry ? nullptr : WSP(float, WS_SS) + 2 * M, dry ? 8191 : 0x7fffffff};
    gemm_phase<EpiRes, StaticOrder, true, true>(c.lds, g, S, E);
}
__device__ __forceinline__ void ph8(const Ctx& c) {
    using namespace pg8;
    Gemm g{WSP(bf16, WS_HB), WSP(const bf16, WS_WFI), M, 2 * FFN, D}; StaticOrder S; S.init(M, 2 * FFN, c.G, c.bx);
    EpiFfn E{WSP(bf16, WS_ACT), WSP(const float, WS_SS) + 2 * M};
    gemm_phase<EpiFfn, StaticOrder, true, true>(c.lds, g, S, E);
}
#ifndef REP_NULL
#define REP_NULL -1
#endif
template <int K_, int N_> __device__ __forceinline__ void ph_null(const Ctx& c, size_t a_off, size_t w_off) {
    using namespace pg8;
    Gemm g{WSP(bf16, a_off), WSP(const bf16, w_off), M, N_, K_}; StaticOrder S; S.init(M, N_, c.G, c.bx);
    EpiNull E{WSP(float, WS_XB)};
    gemm_phase<EpiNull, StaticOrder, true, true>(c.lds, g, S, E);
}
__device__ __forceinline__ void ph9(const Ctx& c, bool dry) {
    using namespace pg8;
    Gemm g{WSP(bf16, WS_ACT), WSP(const bf16, WS_WFO), M, D, FFN}; StaticOrder S; S.init(M, D, c.G, c.bx);
    EpiRes E{c.a->out, dry ? WSP(float, WS_XB) : c.a->out, nullptr, nullptr, dry ? 8191 : 0x7fffffff};
    gemm_phase<EpiRes, StaticOrder, true, true>(c.lds, g, S, E);
}
__device__ __forceinline__ void ph10(const Ctx& c, bool dry) {
    const float* gf = c.a->in[17];
    for (int m = c.gw; m < M; m += c.NGW) {
        f32x4* r = (f32x4*)(c.a->out + (size_t)m * D) + c.lane; f32x4* w = dry ? (f32x4*)(WSP(float, WS_XB) + (size_t)(m & 8191) * D) + c.lane : r; const f32x4* gr = (const f32x4*)gf + c.lane; f32x4 vv[8]; float s = 0.f;
#pragma unroll
        for (int j = 0; j < 8; ++j) { vv[j] = r[64 * j]; s += (vv[j].x * vv[j].x + vv[j].y * vv[j].y) + (vv[j].z * vv[j].z + vv[j].w * vv[j].w); }
        const float rs = __builtin_amdgcn_rsqf(wave_sum(s) * (1.0f / D) + EPS);
#pragma unroll
        for (int j = 0; j < 8; ++j) w[64 * j] = vv[j] * rs * gr[64 * j];
    }
}

__global__ void __launch_bounds__(NTHREADS, 2) fwd_mega(Args a) {
    extern __shared__ __attribute__((aligned(16))) unsigned char lds_raw[];
    Ctx c; c.a = &a; c.lds = (LAS unsigned char*)lds_raw;
    c.tid = threadIdx.x; c.lane = c.tid & 63; c.wave = __builtin_amdgcn_readfirstlane(c.tid >> 6);
    c.G = gridDim.x; c.bx = blockIdx.x;
    c.vcu = (c.G % 8 == 0) ? (c.bx % 8) * (c.G / 8) + c.bx / 8 : c.bx;
    c.gw = c.vcu * NWAVES + c.wave; c.NGW = c.G * NWAVES;
    volatile LAS unsigned* st = (volatile LAS unsigned*)(c.lds + LDS_BYTES - 64);
    if (c.tid < 16) st[c.tid] = 0u;
    __syncthreads();
    const XcdBarrier bar = xcd_barrier_post((unsigned*)(a.ws + WS_BAR), st);
#if USE_CG_FIRST
    cg::grid_group grid = cg::this_grid();
#endif
#define BAR() xcd_barrier(bar)
#define RUN(k, call) do { call; if (REP_PH == (k)) { BAR(); call; } } while (0)
    RUN(0, p0_prologue(a, c.lds, c.gw, c.NGW, c.wave, c.lane));
#if USE_CG_FIRST
    grid.sync();
#else
    BAR();
#endif
    RUN(1, ph1(c)); BAR();
    if (REP_PH == 2) { ph2(c, true); BAR(); }
    ph2(c, false); BAR();
    RUN(3, ph3(c)); BAR();
    if (REP_PH == 4) { ph4(c, false); BAR(); }
    if (REP_NULL == 4) { ph_null<D, D>(c, WS_XB, WS_WMO); BAR(); }
    ph4(c, true); BAR();
    RUN(5, ph5(c)); BAR();
    if (REP_PH == 6) { ph6(c, true); BAR(); }
    ph6(c, false); BAR();
    if (REP_PH == 7) { ph7(c, true); BAR(); }
    ph7(c, false); BAR();
    RUN(8, ph8(c)); BAR();
    if (REP_PH == 9) { ph9(c, true); BAR(); }
    if (REP_NULL == 9) { ph_null<FFN, D>(c, WS_ACT, WS_WFO); BAR(); }
    if (REP_NULL == 8) { ph_null<D, 2 * FFN>(c, WS_HB, WS_WFI); BAR(); }
    ph9(c, false); BAR();
    if (REP_PH == 10) { ph10(c, true); BAR(); }
    ph10(c, false);
    for (int rp = 0; rp < REP_SYNC; ++rp) BAR();
#undef RUN
#undef BAR
}

extern "C" void kernel_launch(void* const* d_in, const int* in_sizes, int n_in, void* d_out, int out_size, void* d_ws, size_t ws_size, hipStream_t stream) {
    static int grid = 0;
    if (grid == 0) {
        if (n_in != 18 || out_size != M * D || ws_size < WS_END) { fprintf(stderr, "kernel_launch: unexpected shapes (n_in %d out %d ws %zu)\n", n_in, out_size, ws_size); grid = -1; return; }
        int dev = 0, cus = 0, per_cu = 0;
        if (hipGetDevice(&dev) != hipSuccess || hipDeviceGetAttribute(&cus, hipDeviceAttributeMultiprocessorCount, dev) != hipSuccess) { grid = -1; return; }
        if (hipFuncSetAttribute((const void*)fwd_mega, hipFuncAttributeMaxDynamicSharedMemorySize, LDS_BYTES) != hipSuccess) { fprintf(stderr, "kernel_launch: hipFuncSetAttribute failed\n"); grid = -1; return; }
        if (hipOccupancyMaxActiveBlocksPerMultiprocessor(&per_cu, (const void*)fwd_mega, NTHREADS, LDS_BYTES) != hipSuccess || per_cu < 1) { fprintf(stderr, "kernel_launch: occupancy query says %d blocks per CU\n", per_cu); (void)hipGetLastError(); grid = -1; return; }
        grid = cus;
    }
    if (grid < 0) return;
    (void)hipMemsetAsync((char*)d_ws + WS_SS + (size_t)M * 4, 0, WS_BAR + 16384 - (size_t)M * 4, stream);
    Args a{};
    for (int i = 0; i < 18; ++i) a.in[i] = (const float*)d_in[i];
    a.out = (float*)d_out; a.ws = (unsigned char*)d_ws; a.ph_lo = 0; a.ph_hi = 11;
    void* args[] = {&a};
    hipError_t e = hipLaunchCooperativeKernel((const void*)fwd_mega, dim3(grid), dim3(NTHREADS), args, LDS_BYTES, stream);
    if (e != hipSuccess) fprintf(stderr, "kernel_launch: cooperative launch failed: %s (grid %d)\n", hipGetErrorString(e), grid);
}
```

```cpp
#include <hip/hip_runtime.h>
#include <hip/hip_cooperative_groups.h>
#include <cstdio>
#include <cstdint>
namespace cg = cooperative_groups;
#ifndef USE_CG_FIRST
#define USE_CG_FIRST 0
#endif
namespace pg8 {
#define PG8_LAS __attribute__((address_space(3)))
typedef unsigned short bf16_t;
typedef short bf16x8 __attribute__((ext_vector_type(8)));
typedef float f32x4 __attribute__((ext_vector_type(4)));
typedef unsigned u32x4 __attribute__((ext_vector_type(4)));
constexpr int BM = 256, BK = 64, HALF = 128, HTB = HALF * BK * 2  , STAGE_BYTES = 8 * HTB, NXCD = 8, WGM = 8;

__host__ __device__ __forceinline__ int lds_byte(int r, int c) { const int st = (r >> 4) * 2 + (c >> 5), rr = r & 15, cc = c & 31, ob = rr * 64 + cc * 2; return st * 1024 + (ob ^ (((ob >> 9) & 1) << 5)); }
__host__ __device__ __forceinline__ void stage_rc(int b, int& R, int& C) { const int st = b / 1024, sb = b % 1024, swz = sb ^ (((sb >> 9) & 1) << 5); R = (st >> 1) * 16 + swz / 64; C = (st & 1) * 32 + (swz % 64) / 2; }
__host__ __device__ __forceinline__ int perm32(int rho) { const int n = rho >> 4, i = rho & 15; return 8 * (i >> 2) + 4 * n + (i & 3); }

struct Unit { int pm, pn; };
struct Gemm { const bf16_t* A; const bf16_t* Bt; int M, N, K; };

struct StaticOrder {
    int nM, nN, nwg, G, c;
    __host__ __device__ void init(int M, int N, int G_, int c_) { nM = M / BM; nN = N / BM; nwg = nM * nN; G = G_; c = c_; }
    __host__ __device__ bool next(int i, Unit& u) const {
        const long L = (long)i * G + c; if (L >= nwg) return false;
        int wgid = (int)L; { const int q = nwg / NXCD, r = nwg % NXCD, xcd = wgid % NXCD, off = wgid / NXCD; wgid = (xcd < r ? xcd * (q + 1) : r * (q + 1) + (xcd - r) * q) + off; }
        const int nig = WGM * nN, gid = wgid / nig, fm = gid * WGM, gsz = (nM - fm) < WGM ? (nM - fm) : WGM;
        u.pm = fm + ((wgid % nig) % gsz); u.pn = (wgid % nig) / gsz; return true;
    }
    __device__ __forceinline__ void a_ready(const Unit&) const {}
    __device__ __forceinline__ void done(const Unit&) const {}
};

__device__ __forceinline__ unsigned cvt_pk_bf16(float lo, float hi) { unsigned r; asm volatile("v_cvt_pk_bf16_f32 %0, %1, %2" : "=v"(r) : "v"(lo), "v"(hi)); return r; }
typedef float f32x2 __attribute__((ext_vector_type(2)));
template <class Epi, class Sched, bool ALIGN_EPI = false, bool SP2 = false>
__device__ __forceinline__ void gemm_phase(PG8_LAS unsigned char* lds, const Gemm g, const Sched& S, const Epi& E) {
    const int tid = threadIdx.x, wid = __builtin_amdgcn_readfirstlane(tid >> 6), lane = tid & 63, wr = wid >> 2, wc = wid & 3, fr = lane & 15, fq = lane >> 4;
    const int K = g.K, nt = K / BK;
    unsigned voffA[2], voffB[2];
#pragma unroll
    for (int i = 0; i < 2; ++i) { int R, C; stage_rc(tid * 16 + i * 8192, R, C); const int Rb = Epi::PERM ? ((R & ~31) + perm32(R & 31)) : R;
        voffA[i] = (unsigned)(R * K + C) * 2u; voffB[i] = (unsigned)(Rb * K + C) * 2u; }
    const size_t kstep = (size_t)(BK * 2);
    const size_t hstep = (size_t)HALF * K * 2;
    const size_t tstep = 2 * hstep;
    const unsigned ldsw = (unsigned)wid * 1024u;
    const int aoff = lds_byte(wr * 64 + fr, fq * 8), boff = lds_byte(wc * 32 + fr, fq * 8);
#define PG8_SA(b, h) (((b) * 2 + (h)) * HTB)
#define PG8_SB(b, h) ((4 + (b) * 2 + (h)) * HTB)
#define PG8_STAGE(bufoff, gbase, voff) do { _Pragma("unroll") for (int _i = 0; _i < 2; ++_i) \
        __builtin_amdgcn_global_load_lds((const unsigned*)((const char*)(gbase) + (voff)[_i]), (PG8_LAS unsigned*)(lds + (bufoff) + ldsw + _i * 8192), 16, 0, 0); } while (0)
#define PG8_LDA(dst, b, h) do { _Pragma("unroll") for (int m = 0; m < 4; ++m) _Pragma("unroll") for (int k = 0; k < 2; ++k) dst[m][k] = *(const PG8_LAS bf16x8*)(lds + PG8_SA(b, h) + aoff + m * 2048 + k * 1024); } while (0)
#define PG8_LDB(dst, b, h) do { _Pragma("unroll") for (int n = 0; n < 2; ++n) _Pragma("unroll") for (int k = 0; k < 2; ++k) dst[n][k] = *(const PG8_LAS bf16x8*)(lds + PG8_SB(b, h) + boff + n * 2048 + k * 1024); } while (0)
#define PG8_MMA(ai, bj, At, Bt) do { __builtin_amdgcn_s_setprio(1); _Pragma("unroll") for (int m = 0; m < 4; ++m) _Pragma("unroll") for (int n = 0; n < 2; ++n) _Pragma("unroll") for (int k = 0; k < 2; ++k) \
        acc[ai][bj][m][n] = __builtin_amdgcn_mfma_f32_16x16x32_bf16(Bt[n][k], At[m][k], acc[ai][bj][m][n], 0, 0, 0); __builtin_amdgcn_s_setprio(0); } while (0)
#define PG8_WAIT_V(n) asm volatile("s_waitcnt vmcnt(" #n ")" ::: "memory")
#define PG8_WAIT_L(n) asm volatile("s_waitcnt lgkmcnt(" #n ")" ::: "memory")
#define PG8_BAR __builtin_amdgcn_s_barrier()
#define PG8_SCHED __builtin_amdgcn_sched_barrier(0)
    Unit cur, nxt; int ui = 0;
    if (!S.next(0, cur)) return;
    f32x4 acc[2][2][4][2];
#pragma unroll
    for (int a = 0; a < 2; ++a)
#pragma unroll
        for (int b = 0; b < 2; ++b)
#pragma unroll
            for (int m = 0; m < 4; ++m)
#pragma unroll
                for (int n = 0; n < 2; ++n) acc[a][b][m][n] = (f32x4){0.f, 0.f, 0.f, 0.f};
    bf16x8 At[4][2], B0[2][2], B1[2][2];
    const char* cA = (const char*)g.A + (size_t)cur.pm * tstep; const char* cB = (const char*)g.Bt + (size_t)cur.pn * tstep;
    S.a_ready(cur);
    if constexpr (SP2) {
        PG8_STAGE(PG8_SB(0, 0), cB, voffB); PG8_STAGE(PG8_SB(0, 1), cB + hstep, voffB); PG8_STAGE(PG8_SA(0, 0), cA, voffA); PG8_STAGE(PG8_SA(0, 1), cA + hstep, voffA);
        if (wr == 1) PG8_BAR;
        PG8_WAIT_V(2); PG8_BAR;
        PG8_STAGE(PG8_SB(1, 0), cB + kstep, voffB); PG8_STAGE(PG8_SA(1, 0), cA + kstep, voffA); PG8_STAGE(PG8_SB(1, 1), cB + hstep + kstep, voffB);
        PG8_WAIT_V(6); PG8_BAR;
    } else {
        PG8_STAGE(PG8_SB(0, 0), cB, voffB); PG8_STAGE(PG8_SA(0, 0), cA, voffA); PG8_STAGE(PG8_SB(0, 1), cB + hstep, voffB); PG8_STAGE(PG8_SA(0, 1), cA + hstep, voffA);
        if (wr == 1) PG8_BAR;
        PG8_WAIT_V(4); PG8_BAR;
        PG8_STAGE(PG8_SB(1, 0), cB + kstep, voffB); PG8_STAGE(PG8_SA(1, 0), cA + kstep, voffA); PG8_STAGE(PG8_SB(1, 1), cB + hstep + kstep, voffB);
        PG8_WAIT_V(6); PG8_BAR;
    }
    for (;;) {
        const bool has_next = S.next(ui + 1, nxt);
        const char* nA = has_next ? (const char*)g.A + (size_t)nxt.pm * tstep : cA; const char* nB = has_next ? (const char*)g.Bt + (size_t)nxt.pn * tstep : cB;
        for (int t = 0; t < nt; t += 2) {
            const bool last = (t == nt - 2);
            const char* a1 = cA + (size_t)(t + 1) * kstep;
            const char* a2 = last ? nA : cA + (size_t)(t + 2) * kstep; const char* b2 = last ? nB : cB + (size_t)(t + 2) * kstep;
            const char* a3 = a2 + kstep; const char* b3 = b2 + kstep;
            if (last && has_next) S.a_ready(nxt);
            if constexpr (SP2) {
            PG8_LDB(B0, 0, 0); PG8_LDB(B1, 0, 1); PG8_SCHED; PG8_LDA(At, 0, 0); PG8_STAGE(PG8_SA(1, 1), a1 + hstep, voffA);
            PG8_WAIT_V(8); PG8_WAIT_L(0); PG8_BAR; PG8_MMA(0, 0, At, B0); PG8_MMA(0, 1, At, B1); PG8_BAR; PG8_SCHED;
            PG8_LDA(At, 0, 1); PG8_STAGE(PG8_SB(0, 0), b2, voffB); PG8_STAGE(PG8_SB(0, 1), b2 + hstep, voffB); PG8_STAGE(PG8_SA(0, 0), a2, voffA);
            PG8_WAIT_V(8); PG8_WAIT_L(0); PG8_BAR; PG8_MMA(1, 0, At, B0); PG8_MMA(1, 1, At, B1); PG8_BAR; PG8_SCHED;
            PG8_LDB(B0, 1, 0); PG8_LDB(B1, 1, 1); PG8_SCHED; PG8_LDA(At, 1, 0); PG8_STAGE(PG8_SA(0, 1), a2 + hstep, voffA);
            PG8_WAIT_V(8); PG8_WAIT_L(0); PG8_BAR; PG8_MMA(0, 0, At, B0); PG8_MMA(0, 1, At, B1); PG8_BAR; PG8_SCHED;
            PG8_LDA(At, 1, 1); PG8_STAGE(PG8_SB(1, 0), b3, voffB); PG8_STAGE(PG8_SB(1, 1), b3 + hstep, voffB); PG8_STAGE(PG8_SA(1, 0), a3, voffA);
            PG8_WAIT_V(8); PG8_WAIT_L(0); PG8_BAR; PG8_MMA(1, 0, At, B0); PG8_MMA(1, 1, At, B1); PG8_BAR; PG8_SCHED;
            } else {
            PG8_LDB(B0, 0, 0); PG8_SCHED; PG8_LDA(At, 0, 0); PG8_STAGE(PG8_SA(1, 1), a1 + hstep, voffA);
            PG8_WAIT_L(8); PG8_BAR; PG8_WAIT_L(0); PG8_MMA(0, 0, At, B0); PG8_BAR; PG8_SCHED;
            PG8_LDB(B1, 0, 1); PG8_STAGE(PG8_SB(0, 0), b2, voffB);
            PG8_BAR; PG8_WAIT_L(0); PG8_MMA(0, 1, At, B1); PG8_BAR;
            PG8_LDA(At, 0, 1); PG8_STAGE(PG8_SA(0, 0), a2, voffA);
            PG8_BAR; PG8_WAIT_L(0); PG8_MMA(1, 0, At, B0); PG8_BAR; PG8_SCHED;
            PG8_STAGE(PG8_SB(0, 1), b2 + hstep, voffB);
            PG8_WAIT_V(6); PG8_BAR; PG8_MMA(1, 1, At, B1); PG8_BAR;
            PG8_LDB(B0, 1, 0); PG8_SCHED; PG8_LDA(At, 1, 0); PG8_STAGE(PG8_SA(0, 1), a2 + hstep, voffA);
            PG8_WAIT_L(8); PG8_BAR; PG8_WAIT_L(0); PG8_MMA(0, 0, At, B0); PG8_BAR; PG8_SCHED;
            PG8_LDB(B1, 1, 1); PG8_STAGE(PG8_SB(1, 0), b3, voffB);
            PG8_BAR; PG8_WAIT_L(0); PG8_MMA(0, 1, At, B1); PG8_BAR;
            PG8_LDA(At, 1, 1); PG8_STAGE(PG8_SA(1, 0), a3, voffA);
            PG8_BAR; PG8_WAIT_L(0); PG8_MMA(1, 0, At, B0); PG8_BAR; PG8_SCHED;
            PG8_STAGE(PG8_SB(1, 1), b3 + hstep, voffB);
            PG8_WAIT_V(6); PG8_BAR; PG8_MMA(1, 1, At, B1); PG8_BAR;
            }
        }
        if constexpr (ALIGN_EPI) { if (wr == 0) PG8_BAR; }
        if constexpr (!Epi::AFTER_DRAIN) { E(acc, cur, wr, wc, fr, fq); S.done(cur); }
        if (!has_next) break;
#pragma unroll
        for (int a = 0; a < 2; ++a)
#pragma unroll
            for (int b = 0; b < 2; ++b)
#pragma unroll
                for (int m = 0; m < 4; ++m)
#pragma unroll
                    for (int n = 0; n < 2; ++n) acc[a][b][m][n] = (f32x4){0.f, 0.f, 0.f, 0.f};
        cur = nxt; cA = nA; cB = nB; ++ui;
        if constexpr (ALIGN_EPI) { if (wr == 1) PG8_BAR; }
    }
    PG8_WAIT_V(0);
    if constexpr (!ALIGN_EPI) { if (wr == 0) PG8_BAR; }
    PG8_BAR;
    if constexpr (Epi::AFTER_DRAIN) { E.fused(acc, cur, wr, wc, fr, fq, lds, wid, lane); S.done(cur); }
#undef PG8_SA
#undef PG8_SB
#undef PG8_STAGE
#undef PG8_LDA
#undef PG8_LDB
#undef PG8_MMA
#undef PG8_WAIT_V
#undef PG8_WAIT_L
#undef PG8_BAR
#undef PG8_SCHED
}
constexpr float LOG2E = 1.4426950408889634f;
constexpr float QSCALE = 0.125f * LOG2E;
constexpr float XSCALE = 0.08838834764831845f * LOG2E;
typedef unsigned u32x2 __attribute__((ext_vector_type(2)));
__device__ __forceinline__ float rstd_v(float ssv) { return __builtin_amdgcn_rsqf(ssv * (1.0f / 2048.0f) + 1e-6f); }
__device__ __forceinline__ float rstd_of(const float* ss, int row) { return __builtin_amdgcn_rsqf(ss[row] * (1.0f / 2048.0f) + 1e-6f); }
__device__ __forceinline__ f32x4 sigmoid4(f32x4 v) { f32x4 o;
#pragma unroll
    for (int i = 0; i < 4; ++i) o[i] = __builtin_amdgcn_rcpf(1.0f + __builtin_amdgcn_exp2f(-LOG2E * v[i]));
    return o; }
__device__ __forceinline__ u32x4 pack8(f32x4 a, f32x4 b) { u32x4 w; w.x = cvt_pk_bf16(a[0], a[1]); w.y = cvt_pk_bf16(a[2], a[3]); w.z = cvt_pk_bf16(b[0], b[1]); w.w = cvt_pk_bf16(b[2], b[3]); return w; }
__device__ __forceinline__ void unpack8(u32x4 w, f32x4& a, f32x4& b) {
    a[0] = __uint_as_float(w.x << 16); a[1] = __uint_as_float(w.x & 0xffff0000u); a[2] = __uint_as_float(w.y << 16); a[3] = __uint_as_float(w.y & 0xffff0000u);
    b[0] = __uint_as_float(w.z << 16); b[1] = __uint_as_float(w.z & 0xffff0000u); b[2] = __uint_as_float(w.w << 16); b[3] = __uint_as_float(w.w & 0xffff0000u); }

struct EpiIn {
    static constexpr bool PERM = true, AFTER_DRAIN = false;
    bf16_t *q, *k, *v, *cz, *gb, *sa, *sc; const float* ss; const float* rope;
    __device__ __forceinline__ void operator()(const f32x4 (&acc)[2][2][4][2], const Unit& u, int wr, int wc, int fr, int fq) const {
        const int row0 = u.pm * BM + wr * 64 + fr, pn = u.pn, cl = wc * 32 + 8 * fq;
        if (pn < 5) {
            bf16_t* base = pn < 4 ? q : k; const int ld = pn < 4 ? 1024 : 256, hbase = pn < 4 ? pn * 4 : 0; const float scale = pn < 4 ? QSCALE : 1.0f;
            const int jj = 4 * (wc & 1) + fq;
#pragma unroll
            for (int ai = 0; ai < 2; ++ai) {
                float rr[4]; f32x4 cs[4], sn[4];
#pragma unroll
                for (int m = 0; m < 4; ++m) { const int row = row0 + ai * HALF + m * 16, t = row & 4095; rr[m] = ss[row];
                    cs[m] = *(const f32x4*)(rope + t * 32 + 4 * jj); sn[m] = *(const f32x4*)(rope + 131072 + t * 32 + 4 * jj); }
#pragma unroll
                for (int m = 0; m < 4; ++m) { const int row = row0 + ai * HALF + m * 16; const float r = rstd_v(rr[m]);
#pragma unroll
                    for (int bj = 0; bj < 2; ++bj) { const f32x4 x1 = acc[ai][bj][m][0] * r, x2 = acc[ai][bj][m][1] * r;
                        const f32x4 o1 = (x1 * cs[m] - x2 * sn[m]) * scale, o2 = (x2 * cs[m] + x1 * sn[m]) * scale;
                        bf16_t* p = base + (size_t)row * ld + (hbase + 2 * bj + (wc >> 1)) * 64 + 4 * jj;
                        u32x2 w1, w2; w1.x = cvt_pk_bf16(o1[0], o1[1]); w1.y = cvt_pk_bf16(o1[2], o1[3]); w2.x = cvt_pk_bf16(o2[0], o2[1]); w2.y = cvt_pk_bf16(o2[2], o2[3]);
                        *(u32x2*)p = w1; *(u32x2*)(p + 32) = w2; } }
            }
        } else if (pn >= 6 && pn < 14) {
            bf16_t* base = cz + (pn - 6) * 128 + cl;
#pragma unroll
            for (int ai = 0; ai < 2; ++ai)
#pragma unroll
                for (int m = 0; m < 4; ++m) { const int row = row0 + ai * HALF + m * 16; const float r = rstd_of(ss, row), r2 = r * r;
                    *(u32x4*)(base + (size_t)row * 1024) = pack8(acc[ai][0][m][0] * acc[ai][1][m][0] * r2, acc[ai][0][m][1] * acc[ai][1][m][1] * r2); }
        } else {
            bf16_t* base; int ld; bool sig;
            if (pn == 5) { base = v; ld = 256; sig = false; } else if (pn < 18) { base = gb + (pn - 14) * 256; ld = 1024; sig = false; }
            else if (pn < 26) { base = sa + (pn - 18) * 256; ld = 2048; sig = true; } else { base = sc + (pn - 26) * 256; ld = 2048; sig = true; }
#pragma unroll
            for (int ai = 0; ai < 2; ++ai)
#pragma unroll
                for (int m = 0; m < 4; ++m) { const int row = row0 + ai * HALF + m * 16; const float r = rstd_of(ss, row);
#pragma unroll
                    for (int bj = 0; bj < 2; ++bj) { f32x4 v0 = acc[ai][bj][m][0] * r, v1 = acc[ai][bj][m][1] * r; if (sig) { v0 = sigmoid4(v0); v1 = sigmoid4(v1); }
                        *(u32x4*)(base + (size_t)row * ld + bj * HALF + cl) = pack8(v0, v1); } }
        }
    }
};
struct EpiScale {
    static constexpr bool PERM = true, AFTER_DRAIN = false;
    bf16_t* O; const float* ss; int ldc; float scale;
    __device__ __forceinline__ void operator()(const f32x4 (&acc)[2][2][4][2], const Unit& u, int wr, int wc, int fr, int fq) const {
        const int row0 = u.pm * BM + wr * 64 + fr, col0 = u.pn * BM + wc * 32 + 8 * fq;
#pragma unroll
        for (int ai = 0; ai < 2; ++ai)
#pragma unroll
            for (int m = 0; m < 4; ++m) { const int row = row0 + ai * HALF + m * 16; const float r = (ss ? rstd_of(ss, row) : 1.0f) * scale;
#pragma unroll
                for (int bj = 0; bj < 2; ++bj) *(u32x4*)(O + (size_t)row * ldc + col0 + bj * HALF) = pack8(acc[ai][bj][m][0] * r, acc[ai][bj][m][1] * r); }
    }
};
struct EpiFfn {
    static constexpr bool PERM = true, AFTER_DRAIN = false;
    bf16_t* O; const float* ss;
    __device__ __forceinline__ void operator()(const f32x4 (&acc)[2][2][4][2], const Unit& u, int wr, int wc, int fr, int fq) const {
        const int row0 = u.pm * BM + wr * 64 + fr, col0 = u.pn * HALF + wc * 32 + 8 * fq;
#pragma unroll
        for (int ai = 0; ai < 2; ++ai)
#pragma unroll
            for (int m = 0; m < 4; ++m) { const int row = row0 + ai * HALF + m * 16; const float r = rstd_of(ss, row);
                const f32x4 g0 = acc[ai][0][m][0] * r, g1 = acc[ai][0][m][1] * r, u0 = acc[ai][1][m][0] * r, u1 = acc[ai][1][m][1] * r;
                *(u32x4*)(O + (size_t)row * 5632 + col0) = pack8(g0 * sigmoid4(g0) * u0, g1 * sigmoid4(g1) * u1); }
    }
};
struct EpiT1 {
    static constexpr bool PERM = true, AFTER_DRAIN = false;
    float* T1; const bf16_t* sa;
    __device__ __forceinline__ void operator()(const f32x4 (&acc)[2][2][4][2], const Unit& u, int wr, int wc, int fr, int fq) const {
        const int row0 = u.pm * BM + wr * 64 + fr, col0 = u.pn * BM + wc * 32 + 8 * fq;
#pragma unroll
        for (int ai = 0; ai < 2; ++ai) {
            u32x4 g[4][2];
#pragma unroll
            for (int m = 0; m < 4; ++m)
#pragma unroll
                for (int bj = 0; bj < 2; ++bj) g[m][bj] = *(const u32x4*)(sa + (size_t)(row0 + ai * HALF + m * 16) * 2048 + col0 + bj * HALF);
#pragma unroll
            for (int m = 0; m < 4; ++m) { const size_t off = (size_t)(row0 + ai * HALF + m * 16) * 2048 + col0;
#pragma unroll
                for (int bj = 0; bj < 2; ++bj) { f32x4 g0, g1; unpack8(g[m][bj], g0, g1);
                    *(f32x4*)(T1 + off + bj * HALF) = g0 * acc[ai][bj][m][0]; *(f32x4*)(T1 + off + bj * HALF + 4) = g1 * acc[ai][bj][m][1]; } }
        }
    }
};
struct EpiMerged {
    static constexpr bool PERM = true, AFTER_DRAIN = false;
    const float* T1; const bf16_t* sc; bf16_t* O;
    __device__ __forceinline__ void operator()(const f32x4 (&acc)[2][2][4][2], const Unit& u, int wr, int wc, int fr, int fq) const {
        const int row0 = u.pm * BM + wr * 64 + fr, col0 = u.pn * BM + wc * 32 + 8 * fq;
#pragma unroll
        for (int ai = 0; ai < 2; ++ai)
#pragma unroll
            for (int mh = 0; mh < 2; ++mh) {
                u32x4 g[2][2]; f32x4 t[2][2][2];
#pragma unroll
                for (int mm = 0; mm < 2; ++mm)
#pragma unroll
                    for (int bj = 0; bj < 2; ++bj) { const size_t off = (size_t)(row0 + ai * HALF + (2 * mh + mm) * 16) * 2048 + col0 + bj * HALF;
                        g[mm][bj] = *(const u32x4*)(sc + off); t[mm][bj][0] = *(const f32x4*)(T1 + off); t[mm][bj][1] = *(const f32x4*)(T1 + off + 4); }
#pragma unroll
                for (int mm = 0; mm < 2; ++mm)
#pragma unroll
                    for (int bj = 0; bj < 2; ++bj) { const int m = 2 * mh + mm; const size_t off = (size_t)(row0 + ai * HALF + m * 16) * 2048 + col0 + bj * HALF; f32x4 g0, g1; unpack8(g[mm][bj], g0, g1);
                        *(u32x4*)(O + off) = pack8(t[mm][bj][0] + g0 * acc[ai][bj][m][0], t[mm][bj][1] + g1 * acc[ai][bj][m][1]); }
            }
    }
};
struct EpiRes {
    static constexpr bool PERM = true, AFTER_DRAIN = false;
    const float* base; float* out; bf16_t* ob; float* ss; int rmask;
    __device__ __forceinline__ void operator()(const f32x4 (&acc)[2][2][4][2], const Unit& u, int wr, int wc, int fr, int fq) const {
        const int row0 = u.pm * BM + wr * 64 + fr, col0 = u.pn * BM + wc * 32 + 8 * fq;
#pragma unroll
        for (int ai = 0; ai < 2; ++ai)
#pragma unroll
        for (int mh = 0; mh < 2; ++mh) {
            f32x4 pre[2][2][2];
#pragma unroll
            for (int mm = 0; mm < 2; ++mm)
#pragma unroll
                for (int bj = 0; bj < 2; ++bj) { const float* bp = base + (size_t)(row0 + ai * HALF + (2 * mh + mm) * 16) * 2048 + col0 + bj * HALF; pre[mm][bj][0] = *(const f32x4*)bp; pre[mm][bj][1] = *(const f32x4*)(bp + 4); }
#pragma unroll
            for (int mm = 0; mm < 2; ++mm) { const int m = 2 * mh + mm; const int row = row0 + ai * HALF + m * 16; const size_t off = (size_t)row * 2048 + col0, offo = (size_t)(row & rmask) * 2048 + col0; float s = 0.f;
#pragma unroll
                for (int bj = 0; bj < 2; ++bj) { const f32x4 h0 = pre[mm][bj][0] + acc[ai][bj][m][0], h1 = pre[mm][bj][1] + acc[ai][bj][m][1];
                    *(f32x4*)(out + offo + bj * HALF) = h0; *(f32x4*)(out + offo + bj * HALF + 4) = h1;
                    if (ob) *(u32x4*)(ob + off + bj * HALF) = pack8(h0, h1);
                    s += (h0[0] * h0[0] + h0[1] * h0[1]) + (h0[2] * h0[2] + h0[3] * h0[3]) + (h1[0] * h1[0] + h1[1] * h1[1]) + (h1[2] * h1[2] + h1[3] * h1[3]); }
                if (ss) { s += __shfl_xor(s, 16); s += __shfl_xor(s, 32); if (fq == 0) atomicAdd(ss + row, s); } }
        }
    }
};
struct EpiResB {
    static constexpr bool PERM = true, AFTER_DRAIN = false;
    const bf16_t* base; bf16_t* ob; float* outf; float* ss; int rmask;
    __device__ __forceinline__ void operator()(const f32x4 (&acc)[2][2][4][2], const Unit& u, int wr, int wc, int fr, int fq) const {
        const int row0 = u.pm * BM + wr * 64 + fr, col0 = u.pn * BM + wc * 32 + 8 * fq;
#pragma unroll
        for (int ai = 0; ai < 2; ++ai) {
            u32x4 pre[4][2];
#pragma unroll
            for (int m = 0; m < 4; ++m)
#pragma unroll
                for (int bj = 0; bj < 2; ++bj) pre[m][bj] = *(const u32x4*)(base + (size_t)(row0 + ai * HALF + m * 16) * 2048 + col0 + bj * HALF);
#pragma unroll
            for (int m = 0; m < 4; ++m) { const int row = row0 + ai * HALF + m * 16; const size_t off = (size_t)row * 2048 + col0, offo = (size_t)(row & rmask) * 2048 + col0; float s = 0.f;
#pragma unroll
                for (int bj = 0; bj < 2; ++bj) { f32x4 b0, b1; unpack8(pre[m][bj], b0, b1); const f32x4 h0 = b0 + acc[ai][bj][m][0], h1 = b1 + acc[ai][bj][m][1];
                    if (outf) { *(f32x4*)(outf + offo + bj * HALF) = h0; *(f32x4*)(outf + offo + bj * HALF + 4) = h1; }
                    if (ob) *(u32x4*)(ob + offo + bj * HALF) = pack8(h0, h1);
                    s += (h0[0] * h0[0] + h0[1] * h0[1]) + (h0[2] * h0[2] + h0[3] * h0[3]) + (h1[0] * h1[0] + h1[1] * h1[1]) + (h1[2] * h1[2] + h1[3] * h1[3]); }
                if (ss) { s += __shfl_xor(s, 16); s += __shfl_xor(s, 32); if (fq == 0) atomicAdd(ss + row, s); } }
        }
    }
};
struct EpiNull {
    static constexpr bool PERM = true, AFTER_DRAIN = false;
    float* O;
    __device__ __forceinline__ void operator()(const f32x4 (&acc)[2][2][4][2], const Unit& u, int wr, int wc, int fr, int fq) const {
        f32x4 s = (f32x4){0.f, 0.f, 0.f, 0.f};
#pragma unroll
        for (int ai = 0; ai < 2; ++ai)
#pragma unroll
            for (int bj = 0; bj < 2; ++bj)
#pragma unroll
                for (int m = 0; m < 4; ++m) { s += acc[ai][bj][m][0]; s += acc[ai][bj][m][1]; }
        *(f32x4*)(O + ((size_t)(u.pm * 64 + u.pn) % 4096) * 2048 + threadIdx.x * 4) = s;
    }
};
}

#define LAS __attribute__((address_space(3)))
typedef unsigned short bf16;
typedef unsigned u32x4 __attribute__((ext_vector_type(4)));
typedef unsigned u32x2 __attribute__((ext_vector_type(2)));
typedef float f32x4 __attribute__((ext_vector_type(4)));
typedef float f32x16 __attribute__((ext_vector_type(16)));
typedef short bf16x8 __attribute__((ext_vector_type(8)));
typedef short s16x4 __attribute__((ext_vector_type(4)));
constexpr int NWAVES = 8, NTHREADS = 512;
constexpr int D = 2048, SEQ = 4096, M = 16384, MEMT = 256, MM = 1024, INW = 8704, FFN = 5632, XW = 512;
constexpr float EPS = 1e-6f;
constexpr float LOG2E = 1.4426950408889634f;
constexpr size_t MiB = 1u << 20;
constexpr size_t WS_SS = 0;
constexpr size_t WS_BAR = 256 * 1024;
constexpr size_t WS_ROPE = 1 * MiB;
constexpr size_t WS_MEMN = 2 * MiB;
constexpr size_t WS_KV = 6 * MiB;
constexpr size_t WS_W = 8 * MiB;
constexpr size_t WS_WIN = WS_W;
constexpr size_t WS_WFI = WS_WIN + 34 * MiB;
constexpr size_t WS_WFO = WS_WFI + 44 * MiB;
constexpr size_t WS_WMO = WS_WFO + 22 * MiB;
constexpr size_t WS_WAP = WS_WMO + 8 * MiB;
constexpr size_t WS_WCP = WS_WAP + 4 * MiB;
constexpr size_t WS_WXQ = WS_WCP + 4 * MiB;
constexpr size_t WS_WKV = WS_WXQ + 2 * MiB;
constexpr size_t WS_WXO = WS_WKV + 4 * MiB;
constexpr size_t WS_ACT0 = WS_WXO + 2 * MiB;
static_assert(WS_ACT0 == 132 * MiB, "ws map");
constexpr size_t WS_XB = WS_ACT0;
constexpr size_t WS_Q = WS_XB + 64 * MiB;
constexpr size_t WS_K = WS_Q + 32 * MiB;
constexpr size_t WS_V = WS_K + 8 * MiB;
constexpr size_t WS_CZ = WS_V + 8 * MiB;
constexpr size_t WS_GB = WS_CZ + 32 * MiB;
constexpr size_t WS_SA = WS_GB + 32 * MiB;
constexpr size_t WS_SC = WS_SA + 64 * MiB;
constexpr size_t WS_HB = WS_SC + 64 * MiB;
constexpr size_t WS_ACT = WS_CZ;
constexpr size_t WS_END = WS_HB + 64 * MiB;
constexpr int LDS_BYTES = 147456;

__device__ __forceinline__ float wave_sum(float v) {
#pragma unroll
    for (int o = 1; o < 64; o <<= 1) v += __shfl_xor(v, o);
    return v;
}
__device__ __forceinline__ unsigned f2bf(float f) { unsigned u = __builtin_bit_cast(unsigned, f); return (u + 0x7fffu + ((u >> 16) & 1u)) >> 16; }
__device__ __forceinline__ unsigned pk2(float lo, float hi) { return f2bf(lo) | (f2bf(hi) << 16); }
__device__ __forceinline__ float bflo(unsigned w) { return __uint_as_float(w << 16); }
__device__ __forceinline__ float bfhi(unsigned w) { return __uint_as_float(w & 0xffff0000u); }
__device__ __forceinline__ int crow(int r, int hi) { return (r & 3) + 8 * (r >> 2) + 4 * hi; }
typedef short v4i16_t __attribute__((ext_vector_type(4)));
__device__ __forceinline__ s16x4 vtr(const LAS unsigned char* p) { return __builtin_bit_cast(s16x4, __builtin_amdgcn_ds_read_tr16_b64_v4i16((LAS v4i16_t*)p)); }
#define MFMA32(a, b, c) __builtin_amdgcn_mfma_f32_32x32x16_bf16((a), (b), (c), 0, 0, 0)

__device__ __forceinline__ int src_in(int n) {
    if (n < 1280) { const int p = n & 63; return (n & ~63) + (p & 3) + 4 * (p >> 3) + 32 * ((p >> 2) & 1); }
    if (n < 1536) return n;
    if (n < 3584) { const int it = (n - 1536) >> 8, c = (n - 1536) & 255; return c < 128 ? 1536 + 128 * it + c : 3584 + 128 * it + (c - 128); }
    if (n < 4608) return 2560 + (n - 3584);
    return n;
}
__device__ __forceinline__ int src_ffn(int n) { const int pn = n >> 8, c = n & 255; return c < 128 ? 128 * pn + c : FFN + 128 * pn + (c - 128); }
template <int MAP> __device__ __forceinline__ void p0_transpose_item(const float* W, int ldw, int K, int Np, const float* g, bf16* WT, LAS float* scr, int item, int lane) {
    const int nblk = Np / 64, kb = item / nblk, nb = item % nblk, k0 = 64 * kb, n0 = 64 * nb, c4 = lane & 15, kq = lane >> 4;
    int sc;
    if (MAP == 1) {
        if (n0 < 1280) sc = n0 + 4 * ((c4 >> 1) + 8 * (c4 & 1));
        else if (n0 < 1536) sc = n0 + 4 * c4;
        else if (n0 < 3584) { const int it = (n0 - 1536) >> 8, cc = (n0 - 1536) & 255; sc = (cc < 128 ? 1536 + 128 * it + cc : 3584 + 128 * it + (cc - 128)) + 4 * c4; }
        else if (n0 < 4608) sc = 2560 + (n0 - 3584) + 4 * c4;
        else sc = n0 + 4 * c4;
    } else if (MAP == 2) { const int pn = n0 >> 8, cc = n0 & 255; sc = (cc < 128 ? 128 * pn + cc : FFN + 128 * pn + (cc - 128)) + 4 * c4; }
    else sc = n0 + 4 * c4;
    f32x4 v[16];
#pragma unroll
    for (int i = 0; i < 16; ++i) v[i] = *(const f32x4*)(W + (size_t)(k0 + 4 * i + kq) * ldw + sc);
    if (g) {
#pragma unroll
        for (int i = 0; i < 16; ++i) v[i] = v[i] * g[k0 + 4 * i + kq];
    }
#pragma unroll
    for (int i = 0; i < 16; ++i) { LAS float* d = scr + (4 * i + kq) * 65 + 4 * c4; d[0] = v[i].x; d[1] = v[i].y; d[2] = v[i].z; d[3] = v[i].w; }
    asm volatile("s_waitcnt lgkmcnt(0)" ::: "memory");
    const int c = lane & 7;
#pragma unroll
    for (int j = 0; j < 8; ++j) { const int n = (lane >> 3) + 8 * j; const LAS float* s = scr + (8 * c) * 65 + n;
        u32x4 o; o.x = pk2(s[0 * 65], s[1 * 65]); o.y = pk2(s[2 * 65], s[3 * 65]); o.z = pk2(s[4 * 65], s[5 * 65]); o.w = pk2(s[6 * 65], s[7 * 65]);
        *(u32x4*)(WT + (size_t)(n0 + n) * K + k0 + 8 * c) = o; }
    asm volatile("s_waitcnt lgkmcnt(0)" ::: "memory");
}

struct Args { const float* in[18]; float* out; unsigned char* ws; int ph_lo, ph_hi; };

__device__ __forceinline__ void p0_prologue(const Args& a, LAS unsigned char* lds, int gw, int NGW, int wave, int lane) {
    unsigned char* ws = a.ws;
    LAS float* scr = (LAS float*)(lds + wave * 16640);
    constexpr int I_IN = (D / 64) * (INW / 64), I_FI = (D / 64) * (2 * FFN / 64), I_FO = (FFN / 64) * (D / 64), I_MO = (D / 64) * (D / 64), I_AP = (1024 / 64) * (D / 64), I_CP = I_AP,
                  I_XQ = (D / 64) * (XW / 64), I_KV = (D / 64) * (1024 / 64), I_XO = (XW / 64) * (D / 64);
    constexpr int NITEMS = I_IN + I_FI + I_FO + I_MO + I_AP + I_CP + I_XQ + I_KV + I_XO;
    for (int it = gw; it < NITEMS; it += NGW) {
        int r = it;
        if (r < I_IN) { p0_transpose_item<1>(a.in[3], INW, D, INW, a.in[2], (bf16*)(ws + WS_WIN), scr, r, lane); continue; } r -= I_IN;
        if (r < I_FI) { p0_transpose_item<2>(a.in[15], 2 * FFN, D, 2 * FFN, a.in[14], (bf16*)(ws + WS_WFI), scr, r, lane); continue; } r -= I_FI;
        if (r < I_FO) { p0_transpose_item<0>(a.in[16], D, FFN, D, nullptr, (bf16*)(ws + WS_WFO), scr, r, lane); continue; } r -= I_FO;
        if (r < I_MO) { p0_transpose_item<0>(a.in[8], D, D, D, nullptr, (bf16*)(ws + WS_WMO), scr, r, lane); continue; } r -= I_MO;
        if (r < I_AP) { p0_transpose_item<0>(a.in[6], D, 1024, D, nullptr, (bf16*)(ws + WS_WAP), scr, r, lane); continue; } r -= I_AP;
        if (r < I_CP) { p0_transpose_item<0>(a.in[7], D, 1024, D, nullptr, (bf16*)(ws + WS_WCP), scr, r, lane); continue; } r -= I_CP;
        if (r < I_XQ) { p0_transpose_item<0>(a.in[11], XW, D, XW, a.in[9], (bf16*)(ws + WS_WXQ), scr, r, lane); continue; } r -= I_XQ;
        if (r < I_KV) { p0_transpose_item<0>(a.in[12], 1024, D, 1024, nullptr, (bf16*)(ws + WS_WKV), scr, r, lane); continue; } r -= I_KV;
        p0_transpose_item<0>(a.in[13], D, XW, D, nullptr, (bf16*)(ws + WS_WXO), scr, r, lane);
    }
    const float* x = a.in[0]; bf16* xb = (bf16*)(ws + WS_XB); float* ss0 = (float*)(ws + WS_SS);
    for (int m = 2 * gw; m < M; m += 2 * NGW) {
        const f32x4* xr = (const f32x4*)(x + (size_t)m * D) + lane; u32x2* o = (u32x2*)(xb + (size_t)m * D) + lane; f32x4 v[16];
#pragma unroll
        for (int j = 0; j < 16; ++j) v[j] = xr[64 * j];
        float s0 = 0.f, s1 = 0.f;
#pragma unroll
        for (int j = 0; j < 16; ++j) { const float q = (v[j].x * v[j].x + v[j].y * v[j].y) + (v[j].z * v[j].z + v[j].w * v[j].w); if (j < 8) s0 += q; else s1 += q;
            u32x2 w; w.x = pk2(v[j].x, v[j].y); w.y = pk2(v[j].z, v[j].w); o[64 * j] = w; }
        s0 = wave_sum(s0); s1 = wave_sum(s1); if (lane == 0) { ss0[m] = s0; ss0[m + 1] = s1; }
    }
    const float* mem = a.in[1]; const float* gm = a.in[10]; bf16* memn = (bf16*)(ws + WS_MEMN);
    for (int m = gw; m < MM; m += NGW) {
        const f32x4* xr = (const f32x4*)(mem + (size_t)m * D) + lane; const f32x4* gr = (const f32x4*)gm + lane; u32x2* o = (u32x2*)(memn + (size_t)m * D) + lane; f32x4 v[8]; float s = 0.f;
#pragma unroll
        for (int j = 0; j < 8; ++j) { v[j] = xr[64 * j]; s += (v[j].x * v[j].x + v[j].y * v[j].y) + (v[j].z * v[j].z + v[j].w * v[j].w); }
        const float rs = __builtin_amdgcn_rsqf(wave_sum(s) * (1.0f / D) + EPS);
#pragma unroll
        for (int j = 0; j < 8; ++j) { const f32x4 g = gr[64 * j]; u32x2 w; w.x = pk2(v[j].x * rs * g.x, v[j].y * rs * g.y); w.y = pk2(v[j].z * rs * g.z, v[j].w * rs * g.w); o[64 * j] = w; }
    }
    float* rope = (float*)(ws + WS_ROPE);
    for (int e = gw * 64 + lane; e < 4096 * 32; e += NGW * 64) {
        const int t = e >> 5, i = e & 31;
        const float inv = (float)exp(-(double)i / 32.0 * 9.210340371976184);
        const float ang = (float)t * inv;
        double rev = (double)ang * 0.15915494309189535; rev -= floor(rev + 0.5);
        const double xr = rev * 6.283185307179586, x2 = xr * xr;
        double sn = 0.0, cs = 0.0, ts = xr, tc = 1.0;
#pragma unroll
        for (int n = 0; n < 14; ++n) { cs += tc; sn += ts; tc *= -x2 / (double)((2 * n + 1) * (2 * n + 2)); ts *= -x2 / (double)((2 * n + 2) * (2 * n + 3)); }
        rope[e] = (float)cs; rope[4096 * 32 + e] = (float)sn;
    }
}

constexpr int SWA_KRS = 144, SWA_VOFF = 256 * SWA_KRS, SWA_VIMG = 256 * 64;
__device__ __forceinline__ void swa_unit(LAS unsigned char* lds, int unit, const bf16* Q, bf16* O, const bf16* Kg, const bf16* Vg, const float* sinks) {
    const int tid = threadIdx.x, lane = tid & 63, wid = __builtin_amdgcn_readfirstlane(tid >> 6), r32 = lane & 31, hi = lane >> 5;
    const int hk = unit & 3, nb = (unit >> 2) & 31, b = unit >> 7;
    const int tok0 = b * SEQ + nb * 128;
#pragma unroll
    for (int i = 0; i < 4; ++i) {
        const int c = tid + NTHREADS * i, key = c >> 3, ch = c & 7;
        u32x4 kv = (u32x4){0u, 0u, 0u, 0u}, vv = (u32x4){0u, 0u, 0u, 0u};
        if (nb > 0 || key >= 128) { const size_t go = (size_t)(tok0 - 128 + key) * 256 + hk * 64 + ch * 8; kv = *(const u32x4*)(Kg + go); vv = *(const u32x4*)(Vg + go); }
        *(LAS u32x4*)(lds + key * SWA_KRS + ch * 16) = kv;
        *(LAS u32x4*)(lds + SWA_VOFF + (ch >> 2) * SWA_VIMG + key * 64 + (ch & 3) * 16) = vv;
    }
    __syncthreads();
    const int g = wid >> 1, rh = wid & 1, head = hk * 4 + g;
    const float sink = sinks[head] * LOG2E;
    const float NEG = -__builtin_inff();
    const int q4 = (lane & 15) >> 2, p4 = lane & 3, dh = (lane >> 4) & 1;
    for (int sb = 0; sb < 2; ++sb) {
        const int kb0 = 2 * rh + sb;
        const size_t qo = (size_t)(tok0 + 32 * kb0 + r32) * 1024 + head * 64; const bf16* qp = Q + qo; bf16* op = O + qo;
        bf16x8 qf[4];
#pragma unroll
        for (int ds = 0; ds < 4; ++ds) qf[ds] = *(const bf16x8*)(qp + 16 * ds + 8 * hi);
        f32x16 s[5];
#pragma unroll
        for (int jb = 0; jb < 5; ++jb) {
            const LAS unsigned char* kp = lds + (32 * (kb0 + jb) + r32) * SWA_KRS + hi * 16;
            f32x16 c = {};
#pragma unroll
            for (int ds = 0; ds < 4; ++ds) c = MFMA32(*(const LAS bf16x8*)(kp + ds * 32), qf[ds], c);
            s[jb] = c;
        }
#pragma unroll
        for (int r = 0; r < 16; ++r) { const int kk = crow(r, hi); if (kk <= r32) s[0][r] = NEG; if (kk > r32) s[4][r] = NEG; }
        if (nb == 0) {
#pragma unroll
            for (int jb = 0; jb < 4; ++jb) if (kb0 + jb < 4) {
#pragma unroll
                for (int r = 0; r < 16; ++r) s[jb][r] = NEG; }
        }
        float mx = sink;
#pragma unroll
        for (int jb = 0; jb < 5; ++jb)
#pragma unroll
            for (int r = 0; r < 16; ++r) mx = fmaxf(mx, s[jb][r]);
        mx = fmaxf(mx, __shfl_xor(mx, 32));
        float l = 0.f;
#pragma unroll
        for (int jb = 0; jb < 5; ++jb)
#pragma unroll
            for (int r = 0; r < 16; ++r) { const float p = __builtin_amdgcn_exp2f(s[jb][r] - mx); s[jb][r] = p; l += p; }
        l += __shfl_xor(l, 32); l += __builtin_amdgcn_exp2f(sink - mx);
        bf16x8 pf[5][2];
#pragma unroll
        for (int jb = 0; jb < 5; ++jb)
#pragma unroll
            for (int s2 = 0; s2 < 2; ++s2) { u32x4 w; w.x = pg8::cvt_pk_bf16(s[jb][8 * s2 + 0], s[jb][8 * s2 + 1]); w.y = pg8::cvt_pk_bf16(s[jb][8 * s2 + 2], s[jb][8 * s2 + 3]);
                w.z = pg8::cvt_pk_bf16(s[jb][8 * s2 + 4], s[jb][8 * s2 + 5]); w.w = pg8::cvt_pk_bf16(s[jb][8 * s2 + 6], s[jb][8 * s2 + 7]); pf[jb][s2] = __builtin_bit_cast(bf16x8, w); }
        const float inv = 1.0f / l;
#pragma unroll
        for (int db = 0; db < 2; ++db) {
            const LAS unsigned char* vp = lds + SWA_VOFF + db * SWA_VIMG + (32 * kb0 + 4 * hi + q4) * 64 + dh * 32 + p4 * 8;
            f32x16 o = {};
#pragma unroll
            for (int jb = 0; jb < 5; ++jb)
#pragma unroll
                for (int s2 = 0; s2 < 2; ++s2) { const s16x4 lo = vtr(vp + (32 * jb + 16 * s2) * 64), h8 = vtr(vp + (32 * jb + 16 * s2 + 8) * 64);
                    const bf16x8 vf = (bf16x8){lo[0], lo[1], lo[2], lo[3], h8[0], h8[1], h8[2], h8[3]};
                    o = MFMA32(vf, pf[jb][s2], o); }
#pragma unroll
            for (int gi = 0; gi < 4; ++gi) { u32x2 w; w.x = pg8::cvt_pk_bf16(o[4 * gi] * inv, o[4 * gi + 1] * inv); w.y = pg8::cvt_pk_bf16(o[4 * gi + 2] * inv, o[4 * gi + 3] * inv);
                *(u32x2*)(op + 32 * db + 8 * gi + 4 * hi) = w; }
        }
    }
    __syncthreads();
}
__device__ __forceinline__ void conv_items(const bf16* cz, const bf16* gb, bf16* cv, const float* w, int gtid, int ngt) {
    for (int e = gtid; e < M * 128; e += ngt) {
        const int m = e >> 7, c = (e & 127) * 8, t = m & (SEQ - 1); const size_t off = (size_t)m * 1024 + c;
        const u32x4 z0 = *(const u32x4*)(cz + off), gv = *(const u32x4*)(gb + off);
        u32x4 z1 = (u32x4){0u, 0u, 0u, 0u}, z2 = (u32x4){0u, 0u, 0u, 0u};
        if (t >= 1) z1 = *(const u32x4*)(cz + off - 1024);
        if (t >= 2) z2 = *(const u32x4*)(cz + off - 2048);
        const f32x4 w0a = *(const f32x4*)(w + c), w0b = *(const f32x4*)(w + c + 4), w1a = *(const f32x4*)(w + 1024 + c), w1b = *(const f32x4*)(w + 1024 + c + 4), w2a = *(const f32x4*)(w + 2048 + c), w2b = *(const f32x4*)(w + 2048 + c + 4);
        u32x4 o;
#pragma unroll
        for (int j = 0; j < 4; ++j) {
            const float wl0 = j < 2 ? w0a[2 * j] : w0b[2 * j - 4], wh0 = j < 2 ? w0a[2 * j + 1] : w0b[2 * j - 3];
            const float wl1 = j < 2 ? w1a[2 * j] : w1b[2 * j - 4], wh1 = j < 2 ? w1a[2 * j + 1] : w1b[2 * j - 3];
            const float wl2 = j < 2 ? w2a[2 * j] : w2b[2 * j - 4], wh2 = j < 2 ? w2a[2 * j + 1] : w2b[2 * j - 3];
            const float lo = bflo(gv[j]) * (wl0 * bflo(z2[j]) + wl1 * bflo(z1[j]) + wl2 * bflo(z0[j]));
            const float hh = bfhi(gv[j]) * (wh0 * bfhi(z2[j]) + wh1 * bfhi(z1[j]) + wh2 * bfhi(z0[j]));
            o[j] = pg8::cvt_pk_bf16(lo, hh);
        }
        *(u32x4*)(cv + off) = o;
    }
}

constexpr int XA_KRS = 272, XA_VOFF = 256 * XA_KRS, XA_VIMG = 256 * 64;
static_assert(XA_VOFF + 4 * XA_VIMG <= LDS_BYTES, "xattn LDS");
__device__ __forceinline__ void xattn_unit(LAS unsigned char* lds, int unit, const bf16* XQ, bf16* XO, const bf16* KV) {
    const int tid = threadIdx.x, lane = tid & 63, wid = __builtin_amdgcn_readfirstlane(tid >> 6), r32 = lane & 31, hi = lane >> 5;
    const int rt = unit & 15, h = (unit >> 4) & 3, b = unit >> 6;
#pragma unroll
    for (int i = 0; i < 8; ++i) {
        const int c = tid + NTHREADS * i, key = c >> 4, ch = c & 15; const size_t go = (size_t)(b * MEMT + key) * 1024 + h * 128 + ch * 8;
        const u32x4 kv = *(const u32x4*)(KV + go), vv = *(const u32x4*)(KV + go + 512);
        *(LAS u32x4*)(lds + key * XA_KRS + ch * 16) = kv;
        *(LAS u32x4*)(lds + XA_VOFF + (ch >> 2) * XA_VIMG + key * 64 + (ch & 3) * 16) = vv;
    }
    __syncthreads();
    const size_t qo = (size_t)(b * SEQ + rt * 256 + wid * 32 + r32) * XW + h * 128; const bf16* qp = XQ + qo; bf16* op = XO + qo;
    const int q4 = (lane & 15) >> 2, p4 = lane & 3, dh = (lane >> 4) & 1;
    f32x16 s[8];
#pragma unroll
    for (int jb = 0; jb < 8; ++jb) s[jb] = (f32x16){};
#pragma unroll
    for (int ds = 0; ds < 8; ++ds) {
        const bf16x8 qf = *(const bf16x8*)(qp + 16 * ds + 8 * hi);
#pragma unroll
        for (int jb = 0; jb < 8; ++jb) s[jb] = MFMA32(*(const LAS bf16x8*)(lds + (32 * jb + r32) * XA_KRS + hi * 16 + ds * 32), qf, s[jb]);
    }
    float mx = -__builtin_inff();
#pragma unroll
    for (int jb = 0; jb < 8; ++jb)
#pragma unroll
        for (int r = 0; r < 16; ++r) mx = fmaxf(mx, s[jb][r]);
    mx = fmaxf(mx, __shfl_xor(mx, 32));
    float l = 0.f;
    bf16x8 pf[8][2];
#pragma unroll
    for (int jb = 0; jb < 8; ++jb) {
#pragma unroll
        for (int r = 0; r < 16; ++r) { const float p = __builtin_amdgcn_exp2f(s[jb][r] - mx); s[jb][r] = p; l += p; }
#pragma unroll
        for (int s2 = 0; s2 < 2; ++s2) { u32x4 w; w.x = pg8::cvt_pk_bf16(s[jb][8 * s2 + 0], s[jb][8 * s2 + 1]); w.y = pg8::cvt_pk_bf16(s[jb][8 * s2 + 2], s[jb][8 * s2 + 3]);
            w.z = pg8::cvt_pk_bf16(s[jb][8 * s2 + 4], s[jb][8 * s2 + 5]); w.w = pg8::cvt_pk_bf16(s[jb][8 * s2 + 6], s[jb][8 * s2 + 7]); pf[jb][s2] = __builtin_bit_cast(bf16x8, w); }
    }
    l += __shfl_xor(l, 32);
    const float inv = 1.0f / l;
#pragma unroll
    for (int db = 0; db < 4; ++db) {
        const LAS unsigned char* vp = lds + XA_VOFF + db * XA_VIMG + (4 * hi + q4) * 64 + dh * 32 + p4 * 8;
        f32x16 o = {};
#pragma unroll
        for (int jb = 0; jb < 8; ++jb)
#pragma unroll
            for (int s2 = 0; s2 < 2; ++s2) { const s16x4 lo = vtr(vp + (32 * jb + 16 * s2) * 64), h8 = vtr(vp + (32 * jb + 16 * s2 + 8) * 64);
                const bf16x8 vf = (bf16x8){lo[0], lo[1], lo[2], lo[3], h8[0], h8[1], h8[2], h8[3]};
                o = MFMA32(vf, pf[jb][s2], o); }
#pragma unroll
        for (int gi = 0; gi < 4; ++gi) { u32x2 w; w.x = pg8::cvt_pk_bf16(o[4 * gi] * inv, o[4 * gi + 1] * inv); w.y = pg8::cvt_pk_bf16(o[4 * gi + 2] * inv, o[4 * gi + 3] * inv);
            *(u32x2*)(op + 32 * db + 8 * gi + 4 * hi) = w; }
    }
    __syncthreads();
}


#define RLX_AGENT __ATOMIC_RELAXED, __HIP_MEMORY_SCOPE_AGENT
#define XB_TMO      128
#define XB_XCNT(j)  (256  + 64 * (j))
#define XB_XSUB(j)  (1280 + 64 * (j))
#define XB_XGEN(j)  (2304 + 64 * (j))
#define XB_TOP      3328
#define XB_TOPGEN   3392
#define XCD_BAR_WORDS 3456
#define XB_SPIN_CAP (1u << 18)

__device__ __forceinline__ unsigned xb_ld(unsigned* p)              { return __hip_atomic_load(p, __ATOMIC_RELAXED, __HIP_MEMORY_SCOPE_AGENT); }
__device__ __forceinline__ unsigned xb_add(unsigned* p, unsigned v) { return __hip_atomic_fetch_add(p, v, __ATOMIC_RELAXED, __HIP_MEMORY_SCOPE_AGENT); }
__device__ __forceinline__ unsigned xb_xcc_id() { return (unsigned)__builtin_amdgcn_s_getreg((3 << 11) | 20) & 0xFu; }
#define XB_SPIN(cond, bar) do { unsigned _sp = 0; while (cond) { __builtin_amdgcn_s_sleep(1); \
    if ((++_sp & 255u) == 0u) { if (xb_ld(&(bar)[XB_TMO])) break; if (_sp > XB_SPIN_CAP) { atomicAdd(&(bar)[XB_TMO], 1u); break; } } } } while (0)

struct XcdBarrier {
    unsigned* bar; unsigned x;
    volatile LAS unsigned* st;
};

__device__ __forceinline__ XcdBarrier xcd_barrier_post(unsigned* bar, volatile LAS unsigned* st) {
    XcdBarrier b; b.bar = bar; b.x = xb_xcc_id(); b.st = st;
    if (threadIdx.x == 0) (void)xb_add(&bar[XB_XCNT(b.x)], 1u);
    return b;
}
__device__ __forceinline__ void xcd_barrier_complete(unsigned* bar, unsigned x, unsigned& nloc, unsigned& nx) {
    const unsigned G = gridDim.x * gridDim.y * gridDim.z;
    unsigned sum, cnt, mine, sp = 0u;
    for (;;) {
        sum = 0u; cnt = 0u; mine = 0u;
#pragma unroll
        for (unsigned j = 0; j < 16; ++j) { const unsigned c = xb_ld(&bar[XB_XCNT(j)]); sum += c; cnt += (c > 0u) ? 1u : 0u; mine = (j == x) ? c : mine; }
        if (sum == G) break;
        __builtin_amdgcn_s_sleep(1);
        if ((++sp & 255u) == 0u) { if (xb_ld(&bar[XB_TMO])) break; if (sp > XB_SPIN_CAP) { atomicAdd(&bar[XB_TMO], 1u); break; } }
    }
    nloc = mine > 0u ? mine : 1u; nx = cnt > 0u ? cnt : 1u;
}

__device__ __forceinline__ void xcd_barrier(const XcdBarrier& b) {
    asm volatile("s_waitcnt vmcnt(0)" ::: "memory");
    __syncthreads();
    if (threadIdx.x == 0) {
        unsigned* bar = b.bar;
        __builtin_amdgcn_s_waitcnt(0);
        unsigned nloc = b.st[0], nx = b.st[1];
        if (nloc == 0u) { xcd_barrier_complete(bar, b.x, nloc, nx); b.st[0] = nloc; b.st[1] = nx; }
        const unsigned old = xb_add(&bar[XB_XSUB(b.x)], 1u);
        const unsigned gen = old / nloc;
        if (old + 1u == (gen + 1u) * nloc) {
            __builtin_amdgcn_fence(__ATOMIC_RELEASE, "agent");
            asm volatile("s_waitcnt vmcnt(0)" ::: "memory");
            const unsigned og = xb_add(&bar[XB_TOP], 1u);
            const unsigned tg = og / nx;
            if (og + 1u == (tg + 1u) * nx) xb_add(&bar[XB_TOPGEN], 1u);
            else XB_SPIN(xb_ld(&bar[XB_TOPGEN]) == tg, bar);
            __builtin_amdgcn_fence(__ATOMIC_ACQUIRE, "agent");
            xb_add(&bar[XB_XGEN(b.x)], 1u);
            asm volatile("s_waitcnt vmcnt(0)" ::: "memory");
        } else {
            XB_SPIN(xb_ld(&bar[XB_XGEN(b.x)]) == gen, bar);
            __builtin_amdgcn_fence(__ATOMIC_ACQUIRE, "agent");
            asm volatile("s_waitcnt vmcnt(0)" ::: "memory");
        }
    }
    __syncthreads();
}

#ifndef REP_SYNC
#define REP_SYNC 0
#endif
#ifndef REP_PH
#define REP_PH -1
#endif
struct Ctx {
    const Args* a; LAS unsigned char* lds; int G, bx, vcu, gw, NGW, tid, lane, wave;
};
#define WSP(T, off) ((T*)(c.a->ws + (off)))
__device__ __forceinline__ void ph1(const Ctx& c) {
    using namespace pg8;
    { Gemm g{WSP(bf16, WS_XB), WSP(const bf16, WS_WIN), M, INW, D}; StaticOrder S; S.init(M, INW, c.G, c.bx);
      EpiIn E{WSP(bf16, WS_Q), WSP(bf16, WS_K), WSP(bf16, WS_V), WSP(bf16, WS_CZ), WSP(bf16, WS_GB), WSP(bf16, WS_SA), WSP(bf16, WS_SC), WSP(const float, WS_SS), WSP(const float, WS_ROPE)};
      gemm_phase<EpiIn, StaticOrder, true, true>(c.lds, g, S, E); }
    { Gemm g{WSP(bf16, WS_MEMN), WSP(const bf16, WS_WKV), MM, 1024, D}; StaticOrder S; S.init(MM, 1024, c.G, (c.bx + c.G / 2) % c.G);
      EpiScale E{WSP(bf16, WS_KV), nullptr, 1024, 1.0f};
      gemm_phase<EpiScale, StaticOrder, true, true>(c.lds, g, S, E); }
}
__device__ __forceinline__ void ph2(const Ctx& c, bool dry) {
    bf16* O = dry ? WSP(bf16, WS_HB) : WSP(bf16, WS_Q); bf16* cv = dry ? WSP(bf16, WS_HB + 32 * MiB) : WSP(bf16, WS_GB);
    for (int u = c.bx; u < 512; u += c.G) swa_unit(c.lds, u, WSP(const bf16, WS_Q), O, WSP(const bf16, WS_K), WSP(const bf16, WS_V), c.a->in[5]);
    conv_items(WSP(const bf16, WS_CZ), WSP(const bf16, WS_GB), cv, c.a->in[4], c.vcu * NTHREADS + c.tid, c.G * NTHREADS);
}
__device__ __forceinline__ void ph3a(const Ctx& c) {
    using namespace pg8;
    Gemm g{WSP(bf16, WS_Q), WSP(const bf16, WS_WAP), M, D, 1024}; StaticOrder S; S.init(M, D, c.G, c.bx);
    EpiT1 E{c.a->out, WSP(const bf16, WS_SA)};
    gemm_phase<EpiT1, StaticOrder, true, true>(c.lds, g, S, E);
}
__device__ __forceinline__ void ph3b(const Ctx& c) {
    using namespace pg8;
    Gemm g{WSP(bf16, WS_GB), WSP(const bf16, WS_WCP), M, D, 1024}; StaticOrder S; S.init(M, D, c.G, c.bx);
    EpiMerged E{c.a->out, WSP(const bf16, WS_SC), WSP(bf16, WS_SA)};
    gemm_phase<EpiMerged, StaticOrder, true, true>(c.lds, g, S, E);
}
__device__ __forceinline__ void ph4(const Ctx& c, bool with_ss) {
    using namespace pg8;
    Gemm g{WSP(bf16, WS_SA), WSP(const bf16, WS_WMO), M, D, D}; StaticOrder S; S.init(M, D, c.G, c.bx);
    EpiResB E{WSP(const bf16, WS_XB), WSP(bf16, WS_HB), nullptr, with_ss ? WSP(float, WS_SS) + M : nullptr, 0x7fffffff};
    gemm_phase<EpiResB, StaticOrder, true, true>(c.lds, g, S, E);
}
__device__ __forceinline__ void ph5(const Ctx& c) {
    using namespace pg8;
    Gemm g{WSP(bf16, WS_HB), WSP(const bf16, WS_WXQ), M, XW, D}; StaticOrder S; S.init(M, XW, c.G, c.bx);
    EpiScale E{WSP(bf16, WS_Q), WSP(const float, WS_SS) + M, XW, XSCALE};
    gemm_phase<EpiScale, StaticOrder, true, true>(c.lds, g, S, E);
}
__device__ __forceinline__ void ph6(const Ctx& c, bool dry) { bf16* O = dry ? WSP(bf16, WS_XB) : WSP(bf16, WS_Q); for (int u = c.bx; u < 256; u += c.G) xattn_unit(c.lds, u, WSP(const bf16, WS_Q), O, WSP(const bf16, WS_KV)); }
__device__ __forceinline__ void ph7(const Ctx& c, bool dry) {
    using namespace pg8;
    Gemm g{WSP(bf16, WS_Q), WSP(const bf16, WS_WXO), M, D, XW}; StaticOrder S; S.init(M, D, c.G, c.bx);
    EpiResB E{WSP(const bf16, WS_HB), dry ? WSP(bf16, WS_XB) : WSP(bf16, WS_HB), nullptr, dry ? nullptr : WSP(float, WS_SS) + 2 * M, dry ? 8191 : 0x7fffffff};
    gemm_phase<EpiResB, StaticOrder, true, true>(c.lds, g, S, E);
}
__device__ __forceinline__ void ph8(const Ctx& c) {
    using namespace pg8;
    Gemm g{WSP(bf16, WS_HB), WSP(const bf16, WS_WFI), M, 2 * FFN, D}; StaticOrder S; S.init(M, 2 * FFN, c.G, c.bx);
    EpiFfn E{WSP(bf16, WS_ACT), WSP(const float, WS_SS) + 2 * M};
    gemm_phase<EpiFfn, StaticOrder, true, true>(c.lds, g, S, E);
}
#ifndef REP_NULL
#define REP_NULL -1
#endif
template <int K_, int N_> __device__ __forceinline__ void ph_null(const Ctx& c, size_t a_off, size_t w_off) {
    using namespace pg8;
    Gemm g{WSP(bf16, a_off), WSP(const bf16, w_off), M, N_, K_}; StaticOrder S; S.init(M, N_, c.G, c.bx);
    EpiNull E{WSP(float, WS_XB)};
    gemm_phase<EpiNull, StaticOrder, true, true>(c.lds, g, S, E);
}
__device__ __forceinline__ void ph9(const Ctx& c, bool dry) {
    using namespace pg8;
    Gemm g{WSP(bf16, WS_ACT), WSP(const bf16, WS_WFO), M, D, FFN}; StaticOrder S; S.init(M, D, c.G, c.bx);
    EpiResB E{WSP(const bf16, WS_HB), nullptr, dry ? WSP(float, WS_XB) : c.a->out, nullptr, dry ? 8191 : 0x7fffffff};
    gemm_phase<EpiResB, StaticOrder, true, true>(c.lds, g, S, E);
}
__device__ __forceinline__ void ph10(const Ctx& c, bool dry) {
    const float* gf = c.a->in[17];
    for (int m = c.gw; m < M; m += c.NGW) {
        f32x4* r = (f32x4*)(c.a->out + (size_t)m * D) + c.lane; f32x4* w = dry ? (f32x4*)(WSP(float, WS_XB) + (size_t)(m & 8191) * D) + c.lane : r; const f32x4* gr = (const f32x4*)gf + c.lane; f32x4 vv[8]; float s = 0.f;
#pragma unroll
        for (int j = 0; j < 8; ++j) { vv[j] = r[64 * j]; s += (vv[j].x * vv[j].x + vv[j].y * vv[j].y) + (vv[j].z * vv[j].z + vv[j].w * vv[j].w); }
        const float rs = __builtin_amdgcn_rsqf(wave_sum(s) * (1.0f / D) + EPS);
#pragma unroll
        for (int j = 0; j < 8; ++j) w[64 * j] = vv[j] * rs * gr[64 * j];
    }
}

__global__ void __launch_bounds__(NTHREADS, 2) fwd_mega(Args a) {
    extern __shared__ __attribute__((aligned(16))) unsigned char lds_raw[];
    Ctx c; c.a = &a; c.lds = (LAS unsigned char*)lds_raw;
    c.tid = threadIdx.x; c.lane = c.tid & 63; c.wave = __builtin_amdgcn_readfirstlane(c.tid >> 6);
    c.G = gridDim.x; c.bx = blockIdx.x;
    c.vcu = (c.G % 8 == 0) ? (c.bx % 8) * (c.G / 8) + c.bx / 8 : c.bx;
    c.gw = c.vcu * NWAVES + c.wave; c.NGW = c.G * NWAVES;
    volatile LAS unsigned* st = (volatile LAS unsigned*)(c.lds + LDS_BYTES - 64);
    if (c.tid < 16) st[c.tid] = 0u;
    __syncthreads();
    const XcdBarrier bar = xcd_barrier_post((unsigned*)(a.ws + WS_BAR), st);
#if USE_CG_FIRST
    cg::grid_group grid = cg::this_grid();
#endif
#define BAR() xcd_barrier(bar)
#define RUN(k, call) do { call; if (REP_PH == (k)) { BAR(); call; } } while (0)
    RUN(0, p0_prologue(a, c.lds, c.gw, c.NGW, c.wave, c.lane));
#if USE_CG_FIRST
    grid.sync();
#else
    BAR();
#endif
    RUN(1, ph1(c)); BAR();
    if (REP_PH == 2) { ph2(c, true); BAR(); }
    ph2(c, false); BAR();
    ph3a(c); BAR(); ph3b(c); BAR();
    if (REP_PH == 4) { ph4(c, false); BAR(); }
    ph4(c, true); BAR();
    RUN(5, ph5(c)); BAR();
    if (REP_PH == 6) { ph6(c, true); BAR(); }
    ph6(c, false); BAR();
    if (REP_PH == 7) { ph7(c, true); BAR(); }
    ph7(c, false); BAR();
    RUN(8, ph8(c)); BAR();
    if (REP_PH == 9) { ph9(c, true); BAR(); }
    if (REP_NULL == 9) { ph_null<FFN, D>(c, WS_ACT, WS_WFO); BAR(); }
    if (REP_NULL == 8) { ph_null<D, 2 * FFN>(c, WS_HB, WS_WFI); BAR(); }
    ph9(c, false); BAR();
    if (REP_PH == 10) { ph10(c, true); BAR(); }
    ph10(c, false);
    for (int rp = 0; rp < REP_SYNC; ++rp) BAR();
#undef RUN
#undef BAR
}

extern "C" void kernel_launch(void* const* d_in, const int* in_sizes, int n_in, void* d_out, int out_size, void* d_ws, size_t ws_size, hipStream_t stream) {
    static int grid = 0;
    if (grid == 0) {
        if (n_in != 18 || out_size != M * D || ws_size < WS_END) { fprintf(stderr, "kernel_launch: unexpected shapes (n_in %d out %d ws %zu)\n", n_in, out_size, ws_size); grid = -1; return; }
        int dev = 0, cus = 0, per_cu = 0;
        if (hipGetDevice(&dev) != hipSuccess || hipDeviceGetAttribute(&cus, hipDeviceAttributeMultiprocessorCount, dev) != hipSuccess) { grid = -1; return; }
        if (hipFuncSetAttribute((const void*)fwd_mega, hipFuncAttributeMaxDynamicSharedMemorySize, LDS_BYTES) != hipSuccess) { fprintf(stderr, "kernel_launch: hipFuncSetAttribute failed\n"); grid = -1; return; }
        if (hipOccupancyMaxActiveBlocksPerMultiprocessor(&per_cu, (const void*)fwd_mega, NTHREADS, LDS_BYTES) != hipSuccess || per_cu < 1) { fprintf(stderr, "kernel_launch: occupancy query says %d blocks per CU\n", per_cu); (void)hipGetLastError(); grid = -1; return; }
        grid = cus;
    }
    if (grid < 0) return;
    (void)hipMemsetAsync((char*)d_ws + WS_SS + (size_t)M * 4, 0, WS_BAR + 16384 - (size_t)M * 4, stream);
    Args a{};
    for (int i = 0; i < 18; ++i) a.in[i] = (const float*)d_in[i];
    a.out = (float*)d_out; a.ws = (unsigned char*)d_ws; a.ph_lo = 0; a.ph_hi = 11;
    void* args[] = {&a};
    hipError_t e = hipLaunchCooperativeKernel((const void*)fwd_mega, dim3(grid), dim3(NTHREADS), args, LDS_BYTES, stream);
    if (e != hipSuccess) fprintf(stderr, "kernel_launch: cooperative launch failed: %s (grid %d)\n", hipGetErrorString(e), grid);
}
```
